# Optimizing an MI355X kernel written in HIP

```python
import math
import jax
import jax.numpy as jnp
from jax import lax
import numpy as np

D_MODEL = 1024
BATCH = 8
SEQ = 2048
DEPTH = 2
DEC_BATCH = 16
DEC_SEQ = 16
PAST_LEN = 1024

CHUNK = 64
SGU_CHUNK = 128
Q_BLOCK = 128
MIX_WIDTH = D_MODEL
WIDTH_A = MIX_WIDTH // 2
WIDTH_B = MIX_WIDTH // 2
N_HEADS_A = 4
HEAD_DIM_A = WIDTH_A // N_HEADS_A
N_HEADS_B = 4
HEAD_DIM_V = WIDTH_B // N_HEADS_B
HEAD_DIM_QK = HEAD_DIM_V // 2
QK_WIDTH = N_HEADS_B * 2 * HEAD_DIM_QK
IN_WIDTH = 3 * WIDTH_A + 2 * QK_WIDTH + 2 * WIDTH_B
SPLIT_POINTS = (WIDTH_A, 2 * WIDTH_A, 3 * WIDTH_A,
                3 * WIDTH_A + QK_WIDTH, 3 * WIDTH_A + 2 * QK_WIDTH,
                3 * WIDTH_A + 2 * QK_WIDTH + WIDTH_B)
NORM_EPS = 1e-6
NEG_INF = -1e30

kernel_name = "hybrid_gmlp_diffattn_stream_step"


def rms_norm(x, g):
    xf = x.astype(jnp.float32)
    y = xf * lax.rsqrt(jnp.mean(xf * xf, axis=-1, keepdims=True) + NORM_EPS)
    return (y * g.astype(jnp.float32)).astype(x.dtype)


def alibi_slopes():
    h = jnp.arange(1, N_HEADS_B + 1, dtype=jnp.float32)
    return jnp.exp2(-8.0 * h / N_HEADS_B)


def spatial_gate(v, g, w_s, b_s):
    bsz, t = v.shape[0], v.shape[1]
    length = min(t, SGU_CHUNK)
    n_chunks = t // length
    vn = rms_norm(v, g).reshape(bsz, n_chunks, length, N_HEADS_A, HEAD_DIM_A)
    causal = jnp.tril(jnp.ones((length, length), dtype=w_s.dtype))
    w = w_s[:, :length, :length] * causal
    bias = jnp.transpose(b_s[:, :length])[:, :, None]
    out = jnp.einsum("hts,bnshd->bnthd", w, vn) + bias
    return out.reshape(bsz, t, N_HEADS_A, HEAD_DIM_A)


def diff_attend(q, k, v, q_pos, k_pos, lam):
    s = jnp.einsum("bqhcd,bkhcd->bchqk", q.astype(jnp.float32), k.astype(jnp.float32)) * (HEAD_DIM_QK ** -0.5)
    dist = jnp.abs(q_pos[:, None] - k_pos[None, :]).astype(jnp.float32)
    allowed = (k_pos[None, :] // CHUNK) <= (q_pos[:, None] // CHUNK)
    s = s - alibi_slopes()[None, None, :, None, None] * dist
    s = jnp.where(allowed, s, NEG_INF)
    p = jax.nn.softmax(s, axis=-1)
    a = p[:, 0] - lam * p[:, 1]
    return jnp.einsum("bhqk,bkhd->bqhd", a, v.astype(jnp.float32)).astype(v.dtype)


def mixer_layer(x, pos0, past_k, past_v, layer_idx, blocked,
                norm_g, w_in, sgu_norm_g, sgu_w, sgu_b, q_norm_g, k_norm_g,
                lambda_q1, lambda_k1, lambda_q2, lambda_k2, subln_g, w_out):
    bsz, t = x.shape[0], x.shape[1]
    h = rms_norm(x, norm_g)
    z = jnp.einsum("btd,de->bte", h, w_in)
    u_a, v_a, g_a, q, k, v, g_b = jnp.split(z, SPLIT_POINTS, axis=-1)

    y_a = u_a.reshape(bsz, t, N_HEADS_A, HEAD_DIM_A) * spatial_gate(
        v_a.reshape(bsz, t, N_HEADS_A, HEAD_DIM_A), sgu_norm_g, sgu_w, sgu_b)
    y_a = y_a.reshape(bsz, t, WIDTH_A) * jax.nn.silu(g_a)

    q = rms_norm(q.reshape(bsz, t, N_HEADS_B, 2, HEAD_DIM_QK), q_norm_g)
    k = rms_norm(k.reshape(bsz, t, N_HEADS_B, 2, HEAD_DIM_QK), k_norm_g)
    v = v.reshape(bsz, t, N_HEADS_B, HEAD_DIM_V)
    lam_init = 0.8 - 0.6 * math.exp(-0.3 * layer_idx)
    lam = (jnp.exp(jnp.sum(lambda_q1.astype(jnp.float32) * lambda_k1.astype(jnp.float32)))
           - jnp.exp(jnp.sum(lambda_q2.astype(jnp.float32) * lambda_k2.astype(jnp.float32)))
           + lam_init)
    q_pos = pos0 + jnp.arange(t, dtype=jnp.int32)
    if past_k is None:
        k_all, v_all, k_pos = k, v, q_pos
    else:
        k_all = jnp.concatenate([past_k.astype(k.dtype), k], axis=1)
        v_all = jnp.concatenate([past_v.astype(v.dtype), v], axis=1)
        k_pos = jnp.arange(k_all.shape[1], dtype=jnp.int32)
    if blocked:
        n_blocks = t // Q_BLOCK
        q_blocks = jnp.moveaxis(q.reshape(bsz, n_blocks, Q_BLOCK, N_HEADS_B, 2, HEAD_DIM_QK), 1, 0)
        pos_blocks = q_pos.reshape(n_blocks, Q_BLOCK)
        o = lax.map(lambda args: diff_attend(args[0], k_all, v_all, args[1], k_pos, lam),
                    (q_blocks, pos_blocks))
        o = jnp.moveaxis(o, 0, 1).reshape(bsz, t, N_HEADS_B, HEAD_DIM_V)
    else:
        o = diff_attend(q, k_all, v_all, q_pos, k_pos, lam)
    o = rms_norm(o, subln_g) * (1.0 - lam_init)
    y_b = o.reshape(bsz, t, WIDTH_B) * jax.nn.silu(g_b)

    y = jnp.einsum("bte,ed->btd", jnp.concatenate([y_a, y_b], axis=-1), w_out)
    return (x + y, k, v, v_a)


def setup_inputs(seed: int = 0) -> dict:
    key = jax.random.key(seed)
    ks = jax.random.split(key, 18)
    f32 = jnp.float32

    def nrm(k, shape, scale):
        return scale * jax.random.normal(k, shape, f32)

    return {
        "x_prompt": nrm(ks[0], (BATCH, SEQ, D_MODEL), 1.0),
        "x_sample": nrm(ks[1], (DEC_BATCH, DEC_SEQ, D_MODEL), 1.0),
        "cache_k": nrm(ks[2], (DEPTH, DEC_BATCH, PAST_LEN, N_HEADS_B, 2, HEAD_DIM_QK), 1.0),
        "cache_v": nrm(ks[3], (DEPTH, DEC_BATCH, PAST_LEN, N_HEADS_B, HEAD_DIM_V), 1.0),
        "norm_g": 1.0 + nrm(ks[4], (DEPTH, D_MODEL), 0.05),
        "w_in": nrm(ks[5], (DEPTH, D_MODEL, IN_WIDTH), D_MODEL ** -0.5),
        "sgu_norm_g": 1.0 + nrm(ks[6], (DEPTH, N_HEADS_A, HEAD_DIM_A), 0.05),
        "sgu_w": nrm(ks[7], (DEPTH, N_HEADS_A, SGU_CHUNK, SGU_CHUNK), 0.5 * SGU_CHUNK ** -0.5),
        "sgu_b": 1.0 + nrm(ks[8], (DEPTH, N_HEADS_A, SGU_CHUNK), 0.1),
        "q_norm_g": 1.0 + nrm(ks[9], (DEPTH, HEAD_DIM_QK), 0.05),
        "k_norm_g": 1.0 + nrm(ks[10], (DEPTH, HEAD_DIM_QK), 0.05),
        "lambda_q1": nrm(ks[11], (DEPTH, HEAD_DIM_QK), 0.1),
        "lambda_k1": nrm(ks[12], (DEPTH, HEAD_DIM_QK), 0.1),
        "lambda_q2": nrm(ks[13], (DEPTH, HEAD_DIM_QK), 0.1),
        "lambda_k2": nrm(ks[14], (DEPTH, HEAD_DIM_QK), 0.1),
        "subln_g": 1.0 + nrm(ks[15], (DEPTH, HEAD_DIM_V), 0.05),
        "w_out": nrm(ks[16], (DEPTH, MIX_WIDTH, D_MODEL), MIX_WIDTH ** -0.5),
    }


def reference(x_prompt, x_sample, cache_k, cache_v, norm_g, w_in, sgu_norm_g, sgu_w, sgu_b,
              q_norm_g, k_norm_g, lambda_q1, lambda_k1, lambda_q2, lambda_k2, subln_g, w_out):
    xp, xs = x_prompt, x_sample
    kp_rows, vp_rows, ks_rows, vs_rows, sgu_rows = [], [], [], [], []
    for i in range(DEPTH):
        params = (norm_g[i], w_in[i], sgu_norm_g[i], sgu_w[i], sgu_b[i], q_norm_g[i], k_norm_g[i],
                  lambda_q1[i], lambda_k1[i], lambda_q2[i], lambda_k2[i], subln_g[i], w_out[i])
        xp, kp, vp, _ = mixer_layer(xp, 0, None, None, i, True, *params)
        xs, kn, vn, va = mixer_layer(xs, PAST_LEN, cache_k[i], cache_v[i], i, False, *params)
        kp_rows.append(kp)
        vp_rows.append(vp)
        ks_rows.append(kn)
        vs_rows.append(vn)
        sgu_rows.append(va)
    new_k_prompt = jnp.stack(kp_rows)
    new_v_prompt = jnp.stack(vp_rows)
    new_k_sample = jnp.stack(ks_rows)
    new_v_sample = jnp.stack(vs_rows)
    new_sgu_v_sample = jnp.stack(sgu_rows)
    return (xp, xs, new_k_prompt, new_v_prompt, new_k_sample, new_v_sample, new_sgu_v_sample)
```

```cpp
#include <hip/hip_runtime.h>
#include <hip/hip_cooperative_groups.h>
#include <cstdio>
namespace cg = cooperative_groups;

typedef __attribute__((ext_vector_type(8))) short bf16x8;
typedef __attribute__((ext_vector_type(16))) float f32x16;
typedef __attribute__((ext_vector_type(4))) float f32x4;
typedef __bf16 bf16x2_t __attribute__((ext_vector_type(2)));
typedef float f32x2_t __attribute__((ext_vector_type(2)));
typedef unsigned short ushort_t;
typedef unsigned u32x4 __attribute__((ext_vector_type(4)));
typedef unsigned u32x2 __attribute__((ext_vector_type(2)));

#define DI __device__ __forceinline__
#define MFMA32(a, b, c) __builtin_amdgcn_mfma_f32_32x32x16_bf16((a), (b), (c), 0, 0, 0)
#define MFMA16(a, b, c) __builtin_amdgcn_mfma_f32_16x16x32_bf16((a), (b), (c), 0, 0, 0)
#define GLDS(gp, lp) __builtin_amdgcn_global_load_lds((const unsigned*)(gp), (unsigned*)(lp), 16, 0, 0)
#define WAIT_V(n) asm volatile("s_waitcnt vmcnt(" #n ")" ::: "memory")
#define WAIT_L(n) asm volatile("s_waitcnt lgkmcnt(" #n ")" ::: "memory")
#define BAR __builtin_amdgcn_s_barrier()
#define SCHED __builtin_amdgcn_sched_barrier(0)
#define LDS_BARRIER() do { asm volatile("s_waitcnt lgkmcnt(0)" ::: "memory"); __builtin_amdgcn_s_barrier(); asm volatile("" ::: "memory"); } while (0)
#define DSR(dst, addr, imm) asm volatile("ds_read_b128 %0, %1 offset:%2" : "=v"(dst) : "v"(addr), "n"(imm))

constexpr int DM = 1024, NIN = 3584, TP = 16384, TT = 16640;
constexpr int SROWS = 1088;
constexpr float EPS = 1e-6f;
constexpr float LOG2E = 1.4426950408889634f;

constexpr size_t OKP = 17039360, OVP = 33816576, OKS = 50593792, OVS = 50855936, OSGU = 51118080;

constexpr size_t SZ_ACT = (size_t)TT * 512 * 2;
constexpr size_t WS_WIN = 0;
constexpr size_t WS_WOUT = WS_WIN + (size_t)2 * NIN * DM * 2;
constexpr size_t WS_XB = WS_WOUT + (size_t)2 * DM * DM * 2;
constexpr size_t WS_UG = WS_XB + (size_t)TT * 1024 * 2;
constexpr size_t WS_Q = WS_UG + SZ_ACT;
constexpr size_t WS_K = WS_Q + SZ_ACT;
constexpr size_t WS_GB = WS_K + SZ_ACT;
constexpr size_t WS_VNT = WS_GB + SZ_ACT;
constexpr size_t WS_VNS = WS_VNT + (size_t)32 * 128 * 2048 * 2;
constexpr size_t WS_VT = WS_VNS + (size_t)256 * 512 * 2;
constexpr size_t WS_Y = WS_VT + (size_t)32 * 128 * 2048 * 2;
constexpr size_t WS_KSB = WS_Y + (size_t)TT * 1024 * 2;
constexpr size_t WS_VTS = WS_KSB + (size_t)2 * 16 * SROWS * 512 * 2;
constexpr size_t WS_SSQ = WS_VTS + (size_t)2 * 16 * 4 * 128 * SROWS * 2;
constexpr size_t WS_PAR = WS_SSQ + (size_t)2 * TT * 4;
constexpr size_t WS_BAR = WS_PAR + 256;
constexpr size_t WS_END = WS_BAR + 16384;
static_assert(WS_END <= (size_t)256 * 1024 * 1024, "workspace too large");

constexpr int EX_OFF = 131072;
constexpr int RS_OFF = 131072 + 4096;
constexpr int SMEM_BYTES = 131072 + 4096 + 1024 + 64;

struct Params {
  const float* x_prompt; const float* x_sample; const float* cache_k; const float* cache_v;
  const float* norm_g; const float* w_in; const float* sgu_norm_g; const float* sgu_w; const float* sgu_b;
  const float* q_norm_g; const float* k_norm_g; const float* lq1; const float* lk1; const float* lq2; const float* lk2;
  const float* subln_g; const float* w_out;
  float* out; char* ws;
};
struct PW : Params { int wv; };
__device__ __forceinline__ int tidx(const Params& p) {
  int lane;
  asm volatile("v_mbcnt_lo_u32_b32 %0, -1, 0\n\tv_mbcnt_hi_u32_b32 %0, -1, %0" : "=v"(lane));
  return static_cast<const PW&>(p).wv * 64 + lane;
}

DI unsigned pk(float a, float b) {
  f32x2_t v = {a, b};
  bf16x2_t r = __builtin_convertvector(v, bf16x2_t);
  return __builtin_bit_cast(unsigned, r);
}
DI float bflo(unsigned u) { return __uint_as_float(u << 16); }
DI float bfhi(unsigned u) { return __uint_as_float(u & 0xffff0000u); }
DI float silu(float v) { return v * __builtin_amdgcn_rcpf(1.f + __expf(-v)); }
DI u32x4 pk8(f32x4 a, f32x4 b) {
  u32x4 r; r.x = pk(a.x, a.y); r.y = pk(a.z, a.w); r.z = pk(b.x, b.y); r.w = pk(b.z, b.w); return r;
}
DI int kperm(int k16) { return 8 * ((k16 >> 2) & 1) + (k16 & 3) + 4 * (k16 >> 3); }
DI int kinv(int p16) { return 8 * ((p16 & 7) >> 2) + 4 * (p16 >> 3) + (p16 & 3); }

struct TTRegs { f32x4 v[2]; float g[2]; };
DI void tt_load(TTRegs& R, const float* src, size_t sstride, const float* g, int t) {
#pragma unroll
  for (int i = 0; i < 2; ++i) {
    const int f = t + 512 * i, r = f >> 4, c4 = f & 15;
    R.v[i] = *(const f32x4*)(src + (size_t)r * sstride + c4 * 4);
    R.g[i] = g ? g[r] : 1.f;
  }
}
DI void tt_to_lds(const TTRegs& R, float* tile, int t) {
#pragma unroll
  for (int i = 0; i < 2; ++i) {
    const int f = t + 512 * i, r = f >> 4, c4 = f & 15;
    float* tp = tile + r * 65 + c4 * 4;
    tp[0] = R.v[i].x * R.g[i]; tp[1] = R.v[i].y * R.g[i]; tp[2] = R.v[i].z * R.g[i]; tp[3] = R.v[i].w * R.g[i];
  }
}
DI void tt_store(ushort_t* dst, size_t dstride, bool perm, const float* tile, int t) {
  const int c = t >> 3, k8 = t & 7;
  float v[8];
#pragma unroll
  for (int e = 0; e < 8; ++e) {
    const int p = k8 * 8 + e;
    const int r = perm ? ((p & ~15) + kinv(p & 15)) : p;
    v[e] = tile[r * 65 + c];
  }
  u32x4 o; o.x = pk(v[0], v[1]); o.y = pk(v[2], v[3]); o.z = pk(v[4], v[5]); o.w = pk(v[6], v[7]);
  *(u32x4*)(dst + (size_t)c * dstride + k8 * 8) = o;
}

DI int src_section(int sec) {
  const int nt = sec >> 1, ai = sec & 1;
  if (nt < 4) return ai ? 8 + nt : nt;
  if (nt < 6) return 4 + 2 * (nt - 4) + ai;
  if (nt < 10) return ai ? 16 + (nt - 6) : 12 + (nt - 6);
  return ai ? 24 + (nt - 10) : 20 + (nt - 10);
}

DI void phase_prep(const Params& p, char* smem) {
  float* tile = (float*)smem;
  int t_ = tidx(p); asm volatile("" : "+v"(t_));
  const int t = t_, lane = t & 63, w = t >> 6;
  const int G = gridDim.x;
  {
    struct TJob { const float* src; size_t ss; ushort_t* dst; size_t ds; const float* g; bool perm; };
    auto job = [&](int item) {
      TJob J;
      if (item < 2304) {
        const int l = item / 1152;
        int idx = item % 1152;
        if (idx < 896) {
          const int kt = idx / 56, db = idx % 56;
          const int sb = src_section(db >> 1) * 2 + (db & 1);
          J.src = p.w_in + (size_t)l * DM * NIN + (size_t)(kt * 64) * NIN + sb * 64; J.ss = NIN;
          J.dst = (ushort_t*)(p.ws + WS_WIN) + (size_t)l * NIN * DM + (size_t)(db * 64) * DM + kt * 64; J.ds = DM;
          J.g = p.norm_g + l * DM + kt * 64; J.perm = false;
        } else {
          idx -= 896;
          const int kt = idx / 16, nb = idx % 16;
          J.src = p.w_out + (size_t)l * DM * DM + (size_t)(kt * 64) * DM + nb * 64; J.ss = DM;
          J.dst = (ushort_t*)(p.ws + WS_WOUT) + (size_t)l * DM * DM + (size_t)(nb * 64) * DM + kt * 64; J.ds = DM;
          J.g = nullptr; J.perm = false;
        }
      } else {
        const int it = item - 2304;
        const int dh = it & 1, head = (it >> 1) & 3, pt = (it >> 3) & 15, lb = it >> 7;
        J.src = p.cache_v + ((size_t)lb * 1024 + pt * 64) * 512 + head * 128 + dh * 64; J.ss = 512;
        J.dst = (ushort_t*)(p.ws + WS_VTS) + ((size_t)(lb * 4 + head) * 128 + dh * 64) * SROWS + pt * 64; J.ds = SROWS;
        J.g = nullptr; J.perm = true;
      }
      return J;
    };
    constexpr int NJ = 2304 + 4096;
    TTRegs R[4];
    TJob J[4];
    int item = blockIdx.x * 4;
    if (item < NJ) {
#pragma unroll
      for (int u = 0; u < 4; ++u) { J[u] = job(item + u); tt_load(R[u], J[u].src, J[u].ss, J[u].g, t); }
    }
    while (item < NJ) {
      __syncthreads();
#pragma unroll
      for (int u = 0; u < 4; ++u) tt_to_lds(R[u], tile + u * 4160, t);
      __syncthreads();
      TJob Jc[4];
#pragma unroll
      for (int u = 0; u < 4; ++u) Jc[u] = J[u];
      const int nxt = item + G * 4;
      if (nxt < NJ) {
#pragma unroll
        for (int u = 0; u < 4; ++u) { J[u] = job(nxt + u); tt_load(R[u], J[u].src, J[u].ss, J[u].g, t); }
      }
#pragma unroll
      for (int u = 0; u < 4; ++u) tt_store(Jc[u].dst, Jc[u].ds, Jc[u].perm, tile + u * 4160, t);
      item = nxt;
    }
  }
  {
    ushort_t* XB = (ushort_t*)(p.ws + WS_XB);
    float* ssq = (float*)(p.ws + WS_SSQ);
    for (int row0 = (blockIdx.x * 8 + w) * 4; row0 < TT; row0 += G * 32) {
      f32x4 v[4][4];
#pragma unroll
      for (int rr = 0; rr < 4; ++rr) {
        const int row = row0 + rr;
        const float* xr = (row < TP) ? p.x_prompt + (size_t)row * 1024 : p.x_sample + (size_t)(row - TP) * 1024;
#pragma unroll
        for (int i = 0; i < 4; ++i) v[rr][i] = *(const f32x4*)(xr + i * 256 + lane * 4);
      }
#pragma unroll
      for (int rr = 0; rr < 4; ++rr) {
        const int row = row0 + rr;
        float sq = 0.f;
#pragma unroll
        for (int i = 0; i < 4; ++i) {
          const f32x4 a = v[rr][i];
          sq += a.x * a.x + a.y * a.y + a.z * a.z + a.w * a.w;
          u32x2 o; o.x = pk(a.x, a.y); o.y = pk(a.z, a.w);
          *(u32x2*)(XB + (size_t)row * 1024 + i * 256 + lane * 4) = o;
        }
#pragma unroll
        for (int m = 1; m < 64; m <<= 1) sq += __shfl_xor(sq, m);
        if (lane == 0) { ssq[row] = sq; ssq[TT + row] = 0.f; }
      }
    }
  }
  {
    ushort_t* KSB = (ushort_t*)(p.ws + WS_KSB);
    for (int row0 = (blockIdx.x * 8 + w) * 4; row0 < 32768; row0 += G * 32) {
      f32x4 a[4], b4[4];
#pragma unroll
      for (int rr = 0; rr < 4; ++rr) {
        const float* sr = p.cache_k + (size_t)(row0 + rr) * 512 + lane * 8;
        a[rr] = *(const f32x4*)sr; b4[rr] = *(const f32x4*)(sr + 4);
      }
#pragma unroll
      for (int rr = 0; rr < 4; ++rr) {
        const int row = row0 + rr, lb = row >> 10, pos = row & 1023;
        *(u32x4*)(KSB + ((size_t)lb * SROWS + pos) * 512 + lane * 8) = pk8(a[rr], b4[rr]);
      }
    }
  }
  if (blockIdx.x == 0 && w == 0) {
#pragma unroll
    for (int l = 0; l < 2; ++l) {
      float s1 = p.lq1[l * 64 + lane] * p.lk1[l * 64 + lane];
      float s2 = p.lq2[l * 64 + lane] * p.lk2[l * 64 + lane];
      float mq = fabsf(p.q_norm_g[l * 64 + lane]);
      float mk = fabsf(p.k_norm_g[l * 64 + lane]);
#pragma unroll
      for (int m = 1; m < 64; m <<= 1) {
        s1 += __shfl_xor(s1, m); s2 += __shfl_xor(s2, m);
        mq = fmaxf(mq, __shfl_xor(mq, m)); mk = fmaxf(mk, __shfl_xor(mk, m));
      }
      if (lane == 0) {
        const float lam_init = 0.8f - 0.6f * expf(-0.3f * (float)l);
        float* par = (float*)(p.ws + WS_PAR);
        par[l * 4 + 0] = expf(s1) - expf(s2) + lam_init;
        par[l * 4 + 1] = 8.f * mq * mk * 1.03f * LOG2E + 0.25f;
        par[l * 4 + 2] = 1.f - lam_init;
        atomicExch((unsigned*)(p.ws + WS_PAR) + 16 + l, 0u);
      }
    }
  }
}

DI int lds_byte(int r, int c) {
  const int st = (r >> 4) * 2 + (c >> 5), rr = r & 15, cc = c & 31, ob = rr * 64 + cc * 2;
  return st * 1024 + (ob ^ (((ob >> 9) & 1) << 5));
}
DI void stage_rc(int b, int& R, int& C) {
  const int st = b / 1024, sb = b % 1024, swz = sb ^ (((sb >> 9) & 1) << 5);
  R = (st >> 1) * 16 + swz / 64; C = (st & 1) * 32 + (swz % 64) / 2;
}

DI void gemm256(const ushort_t* A, const ushort_t* Bt, f32x4 (&acc)[2][2][4][2], char* shmc, int tid_in) {
  constexpr int K = 1024, BK = 64, HALF = 128, HT = HALF * BK;
  ushort_t* shm = (ushort_t*)shmc;
#define SA(b, h) (shm + ((b) * 2 + (h)) * HT)
#define SB(b, h) (shm + (4 + (b) * 2 + (h)) * HT)
#define STAGE(P, BASE, br, kt) do { const long _g = (long)(br) * K + (long)(kt) * BK; \
    _Pragma("unroll") for (int _i = 0; _i < 2; ++_i) { const int _b = tid * 16 + _i * 8192; int _r, _c; stage_rc(_b, _r, _c); \
      GLDS(BASE + _g + (long)_r * K + _c, (char*)(P) + _b); } } while (0)
#define LDA(dst, b, h) do { const unsigned _a = a_base + ((b) * 2 + (h)) * 16384u; \
    DSR(dst[0][0], _a, 0); DSR(dst[0][1], _a, 1024); DSR(dst[1][0], _a, 2048); DSR(dst[1][1], _a, 3072); \
    DSR(dst[2][0], _a, 4096); DSR(dst[2][1], _a, 5120); DSR(dst[3][0], _a, 6144); DSR(dst[3][1], _a, 7168); } while (0)
#define LDB(dst, b, h) do { const unsigned _a = b_base + (4 + (b) * 2 + (h)) * 16384u; \
    DSR(dst[0][0], _a, 0); DSR(dst[0][1], _a, 1024); DSR(dst[1][0], _a, 2048); DSR(dst[1][1], _a, 3072); } while (0)
#define TIE(Bx) asm volatile("s_waitcnt lgkmcnt(0)" : "+v"(At[0][0]), "+v"(At[0][1]), "+v"(At[1][0]), "+v"(At[1][1]), \
    "+v"(At[2][0]), "+v"(At[2][1]), "+v"(At[3][0]), "+v"(At[3][1]), "+v"(Bx[0][0]), "+v"(Bx[0][1]), "+v"(Bx[1][0]), "+v"(Bx[1][1]))
#define MMA(ai, bj, At_, Bt_) do { __builtin_amdgcn_s_setprio(1); \
    _Pragma("unroll") for (int m = 0; m < 4; ++m) _Pragma("unroll") for (int n = 0; n < 2; ++n) _Pragma("unroll") for (int k = 0; k < 2; ++k) \
      acc[ai][bj][m][n] = MFMA16(At_[m][k], Bt_[n][k], acc[ai][bj][m][n]); \
    __builtin_amdgcn_s_setprio(0); } while (0)

  int tid_ = tid_in; asm volatile("" : "+v"(tid_));
  const int tid = tid_;
  const int wid = tid >> 6, lane = tid & 63, wr = wid >> 2, wc = wid & 3, fr = lane & 15, fq = lane >> 4;
  const unsigned lds0 = (unsigned)(size_t)shmc;
  const unsigned a_base = lds0 + wr * 8192 + lds_byte(fr, fq * 8);
  const unsigned b_base = lds0 + wc * 4096 + lds_byte(fr, fq * 8);
#pragma unroll
  for (int a = 0; a < 2; ++a)
#pragma unroll
    for (int b = 0; b < 2; ++b)
#pragma unroll
      for (int m = 0; m < 4; ++m)
#pragma unroll
        for (int n = 0; n < 2; ++n) acc[a][b][m][n] = (f32x4){0.f, 0.f, 0.f, 0.f};
  bf16x8 At[4][2], B0[2][2], B1[2][2];
  constexpr int nt = K / BK;
  STAGE(SB(0, 0), Bt, 0, 0); STAGE(SA(0, 0), A, 0, 0);
  STAGE(SB(0, 1), Bt, HALF, 0); STAGE(SA(0, 1), A, HALF, 0);
  if (wr == 1) BAR;
  WAIT_V(4); BAR;
  STAGE(SB(1, 0), Bt, 0, 1); STAGE(SA(1, 0), A, 0, 1); STAGE(SB(1, 1), Bt, HALF, 1);
  WAIT_V(6); BAR;
#pragma unroll 1
  for (int t = 0; t < nt - 2; t += 2) {
    LDB(B0, 0, 0); SCHED; LDA(At, 0, 0); STAGE(SA(1, 1), A, HALF, t + 1);
    WAIT_L(8); BAR; TIE(B0); MMA(0, 0, At, B0); BAR; SCHED;
    LDB(B1, 0, 1); STAGE(SB(0, 0), Bt, 0, t + 2);
    BAR; TIE(B1); MMA(0, 1, At, B1); BAR;
    LDA(At, 0, 1); STAGE(SA(0, 0), A, 0, t + 2);
    BAR; TIE(B0); MMA(1, 0, At, B0); BAR; SCHED;
    STAGE(SB(0, 1), Bt, HALF, t + 2);
    WAIT_V(6); BAR; MMA(1, 1, At, B1); BAR;
    LDB(B0, 1, 0); SCHED; LDA(At, 1, 0); STAGE(SA(0, 1), A, HALF, t + 2);
    WAIT_L(8); BAR; TIE(B0); MMA(0, 0, At, B0); BAR; SCHED;
    LDB(B1, 1, 1); STAGE(SB(1, 0), Bt, 0, t + 3);
    BAR; TIE(B1); MMA(0, 1, At, B1); BAR;
    LDA(At, 1, 1); STAGE(SA(1, 0), A, 0, t + 3);
    BAR; TIE(B0); MMA(1, 0, At, B0); BAR; SCHED;
    STAGE(SB(1, 1), Bt, HALF, t + 3);
    WAIT_V(6); BAR; MMA(1, 1, At, B1); BAR;
  }
  { LDB(B0, 0, 0); LDA(At, 0, 0); STAGE(SA(1, 1), A, HALF, nt - 1);
    BAR; TIE(B0); MMA(0, 0, At, B0); BAR;
    LDB(B1, 0, 1); BAR; TIE(B1); MMA(0, 1, At, B1); BAR;
    LDA(At, 0, 1); WAIT_V(4); BAR; TIE(B0); MMA(1, 0, At, B0); MMA(1, 1, At, B1); BAR; }
  { LDB(B0, 1, 0); LDA(At, 1, 0); WAIT_V(2); BAR; TIE(B0); MMA(0, 0, At, B0); BAR;
    LDB(B1, 1, 1); WAIT_V(0); BAR; TIE(B1); MMA(0, 1, At, B1); BAR;
    LDA(At, 1, 1); BAR; TIE(B0); MMA(1, 0, At, B0); MMA(1, 1, At, B1); BAR; }
  if (wr == 0) BAR;
#undef SA
#undef SB
#undef STAGE
#undef LDA
#undef LDB
#undef TIE
#undef MMA
}

DI void phase_in(const Params& p, int l, char* smem) {
  ushort_t* UG = (ushort_t*)(p.ws + WS_UG);
  ushort_t* Qb = (ushort_t*)(p.ws + WS_Q);
  ushort_t* Kb = (ushort_t*)(p.ws + WS_K);
  ushort_t* GB = (ushort_t*)(p.ws + WS_GB);
  ushort_t* VNT = (ushort_t*)(p.ws + WS_VNT);
  ushort_t* VNS = (ushort_t*)(p.ws + WS_VNS);
  ushort_t* VT = (ushort_t*)(p.ws + WS_VT);
  ushort_t* KSB = (ushort_t*)(p.ws + WS_KSB);
  ushort_t* VTS = (ushort_t*)(p.ws + WS_VTS);
  const ushort_t* XB = (const ushort_t*)(p.ws + WS_XB);
  const float* ssq = (const float*)(p.ws + WS_SSQ) + (size_t)l * TT;
  const ushort_t* Wt = (const ushort_t*)(p.ws + WS_WIN) + (size_t)l * NIN * DM;
  float* ex = (float*)(smem + EX_OFF);
  const int G = gridDim.x;
  constexpr int NTILES = 65 * 14;

  for (int id = blockIdx.x; id < NTILES; id += G) {
    int mt, ntile;
    if (id >= 242 && id < 256) { mt = 64; ntile = id - 242; }
    else {
      const int id2 = (id < 242) ? id : id - 14, grp = id2 / (8 * 14), rem = id2 % (8 * 14);
      mt = grp * 8 + (rem & 7); ntile = rem >> 3;
    }
    const float ssq_mine = ssq[mt * 256 + (tidx(p) & 255)];
    f32x4 acc[2][2][4][2];
    gemm256(Wt + (size_t)ntile * 256 * 1024, XB + (size_t)mt * 256 * 1024, acc, smem, tidx(p));

    int t_ = tidx(p); asm volatile("" : "+v"(t_));
    const int tid = t_, wid = tid >> 6, lane = tid & 63, wr = wid >> 2, wc = wid & 3, fr = lane & 15, fq = lane >> 4;
    const bool samp = (mt == 64);
    float* rsl = (float*)(smem + RS_OFF);
    if (tid < 256) rsl[tid] = rsqrtf(ssq_mine * (1.f / 1024.f) + EPS);
    LDS_BARRIER();
    float rs[2][2]; int tok[2][2];
#pragma unroll
    for (int bj = 0; bj < 2; ++bj)
#pragma unroll
      for (int n = 0; n < 2; ++n) {
        const int tl_ = bj * 128 + wc * 32 + n * 16 + fr;
        tok[bj][n] = mt * 256 + tl_;
        rs[bj][n] = rsl[tl_];
      }
    const int sc00 = wr * 64 + fq * 4;

    if (!samp) {
      const int pb = (mt * 256) >> 11, tt0 = (mt * 256) & 2047;
      int tokl[2][2];
#pragma unroll
      for (int bj = 0; bj < 2; ++bj)
#pragma unroll
        for (int n = 0; n < 2; ++n) tokl[bj][n] = bj * 128 + wc * 32 + n * 16 + fr;
      const bool oddl = (fr & 1) != 0;
      auto store_rows = [&](ushort_t* gdst) {
        LDS_BARRIER();
#pragma unroll
        for (int i = 0; i < 8; ++i) {
          const int idx = tid + 512 * i, row = idx >> 4, c = idx & 15;
          const u32x4 v = *(const u32x4*)(smem + row * 272 + c * 16);
          *(u32x4*)(gdst + (size_t)row * 512 + c * 8) = v;
        }
        LDS_BARRIER();
      };
      auto store_tr = [&](ushort_t* gdst) {
        LDS_BARRIER();
#pragma unroll
        for (int i = 0; i < 8; ++i) {
          const int idx = tid + 512 * i, d = idx >> 5, c = idx & 31;
          const u32x4 v = *(const u32x4*)(smem + d * 528 + c * 16);
          *(u32x4*)(gdst + (size_t)d * 2048 + c * 8) = v;
        }
        LDS_BARRIER();
      };
      auto tr_write = [&](int pos, int sc0, unsigned o0, unsigned o1) {
        const unsigned snd = oddl ? o0 : o1;
        const unsigned rcv = (unsigned)__builtin_amdgcn_mov_dpp((int)snd, 0xB1, 0xF, 0xF, true);
        unsigned w0, w1; int d;
        if (!oddl) { w0 = (o0 & 0xffffu) | (rcv << 16); w1 = (o0 >> 16) | (rcv & 0xffff0000u); d = sc0; }
        else { w0 = (rcv & 0xffffu) | (o1 << 16); w1 = (rcv >> 16) | (o1 & 0xffff0000u); d = sc0 + 2; }
        char* ip = smem + d * 528 + (pos >> 1) * 4;
        *(unsigned*)ip = w0; *(unsigned*)(ip + 528) = w1;
      };
      if (ntile < 4) {
        const int cb = ntile * 128;
#pragma unroll
        for (int bj = 0; bj < 2; ++bj)
#pragma unroll
          for (int n = 0; n < 2; ++n) {
            const float r = rs[bj][n];
#pragma unroll
            for (int m = 0; m < 4; ++m) {
              const f32x4 u = acc[0][bj][m][n] * r, g = acc[1][bj][m][n] * r;
              u32x2 o; o.x = pk(u.x * silu(g.x), u.y * silu(g.y)); o.y = pk(u.z * silu(g.z), u.w * silu(g.w));
              *(u32x2*)(smem + tokl[bj][n] * 272 + (sc00 + m * 16) * 2) = o;
            }
          }
        store_rows(UG + (size_t)(mt * 256) * 512 + cb);
      } else if (ntile < 6) {
        float part[2][2][2];
#pragma unroll
        for (int ai = 0; ai < 2; ++ai)
#pragma unroll
          for (int bj = 0; bj < 2; ++bj)
#pragma unroll
            for (int n = 0; n < 2; ++n) {
              float sq = 0.f;
#pragma unroll
              for (int m = 0; m < 4; ++m) {
                const f32x4 v = acc[ai][bj][m][n];
                sq += v.x * v.x + v.y * v.y + v.z * v.z + v.w * v.w;
              }
              sq += __shfl_xor(sq, 16); sq += __shfl_xor(sq, 32);
              part[ai][bj][n] = sq;
              if (fq == 0) ex[((wid * 2 + ai) * 4 + bj * 2 + n) * 16 + fr] = sq;
            }
        __syncthreads();
#pragma unroll
        for (int ai = 0; ai < 2; ++ai) {
          const int head = 2 * (ntile - 4) + ai;
          const float* gp = p.sgu_norm_g + l * 512 + head * 128;
#pragma unroll
          for (int bj = 0; bj < 2; ++bj)
#pragma unroll
            for (int n = 0; n < 2; ++n) {
              const float r = rs[bj][n];
              const float tot = (part[ai][bj][n] + ex[(((wid ^ 4) * 2 + ai) * 4 + bj * 2 + n) * 16 + fr]) * r * r;
              const float rn = rsqrtf(tot * (1.f / 128.f) + EPS) * r;
#pragma unroll
              for (int m = 0; m < 4; ++m) {
                const int sc0 = sc00 + m * 16;
                const f32x4 v = acc[ai][bj][m][n];
                const f32x4 gg = *(const f32x4*)(gp + sc0);
                tr_write(tokl[bj][n], sc0, pk(v.x * rn * gg.x, v.y * rn * gg.y), pk(v.z * rn * gg.z, v.w * rn * gg.w));
              }
            }
          store_tr(VNT + ((size_t)(pb * 4 + head) * 128) * 2048 + tt0);
        }
      } else if (ntile < 10) {
        const int head = ntile - 6, cb = head * 128;
#pragma unroll
        for (int ai = 0; ai < 2; ++ai) {
          const float* gp = (ai == 0 ? p.q_norm_g : p.k_norm_g) + l * 64;
#pragma unroll
          for (int bj = 0; bj < 2; ++bj)
#pragma unroll
            for (int n = 0; n < 2; ++n) {
              float sq = 0.f;
#pragma unroll
              for (int m = 0; m < 4; ++m) {
                const f32x4 v = acc[ai][bj][m][n];
                sq += v.x * v.x + v.y * v.y + v.z * v.z + v.w * v.w;
              }
              sq += __shfl_xor(sq, 16); sq += __shfl_xor(sq, 32);
              const float r = rs[bj][n];
              const float rn = rsqrtf(sq * r * r * (1.f / 64.f) + EPS) * r * (ai == 0 ? 0.125f * LOG2E : 1.f);
              const int tk = tok[bj][n];
#pragma unroll
              for (int m = 0; m < 4; ++m) {
                const int sc0 = sc00 + m * 16;
                const f32x4 gg = *(const f32x4*)(gp + fq * 4 + m * 16);
                const f32x4 v = acc[ai][bj][m][n] * rn * gg;
                u32x2 o; o.x = pk(v.x, v.y); o.y = pk(v.z, v.w);
                if (ai == 1) *(f32x4*)(p.out + OKP + (size_t)l * 8388608 + (size_t)tk * 512 + cb + sc0) = v;
                *(u32x2*)(smem + tokl[bj][n] * 272 + sc0 * 2) = o;
              }
            }
          store_rows((ai == 0 ? Qb : Kb) + (size_t)(mt * 256) * 512 + cb);
        }
      } else {
        const int head = ntile - 10, cb = head * 128;
#pragma unroll
        for (int bj = 0; bj < 2; ++bj)
#pragma unroll
          for (int n = 0; n < 2; ++n) {
            const float r = rs[bj][n];
            const int tk = tok[bj][n];
            const int tl = tokl[bj][n];
            const int pos = (tl & ~15) + kperm(tl & 15);
#pragma unroll
            for (int m = 0; m < 4; ++m) {
              const int sc0 = sc00 + m * 16;
              const f32x4 v = acc[0][bj][m][n] * r;
              *(f32x4*)(p.out + OVP + (size_t)l * 8388608 + (size_t)tk * 512 + cb + sc0) = v;
              tr_write(pos, sc0, pk(v.x, v.y), pk(v.z, v.w));
            }
          }
        store_tr(VT + ((size_t)(pb * 4 + head) * 128) * 2048 + tt0);
#pragma unroll
        for (int bj = 0; bj < 2; ++bj)
#pragma unroll
          for (int n = 0; n < 2; ++n) {
            const float r = rs[bj][n];
#pragma unroll
            for (int m = 0; m < 4; ++m) {
              const f32x4 g = acc[1][bj][m][n] * r;
              u32x2 o; o.x = pk(silu(g.x), silu(g.y)); o.y = pk(silu(g.z), silu(g.w));
              *(u32x2*)(smem + tokl[bj][n] * 272 + (sc00 + m * 16) * 2) = o;
            }
          }
        store_rows(GB + (size_t)(mt * 256) * 512 + cb);
      }
      continue;
    }
    if (ntile < 4) {
      const int cb = ntile * 128;
#pragma unroll
      for (int bj = 0; bj < 2; ++bj)
#pragma unroll
        for (int n = 0; n < 2; ++n) {
          const float r = rs[bj][n];
#pragma unroll
          for (int m = 0; m < 4; ++m) {
            const f32x4 u = acc[0][bj][m][n] * r, g = acc[1][bj][m][n] * r;
            u32x2 o; o.x = pk(u.x * silu(g.x), u.y * silu(g.y)); o.y = pk(u.z * silu(g.z), u.w * silu(g.w));
            *(u32x2*)(UG + (size_t)tok[bj][n] * 512 + cb + sc00 + m * 16) = o;
          }
        }
    } else if (ntile < 6) {
      float part[2][2][2];
#pragma unroll
      for (int ai = 0; ai < 2; ++ai)
#pragma unroll
        for (int bj = 0; bj < 2; ++bj)
#pragma unroll
          for (int n = 0; n < 2; ++n) {
            float s = 0.f;
#pragma unroll
            for (int m = 0; m < 4; ++m) {
              const f32x4 v = acc[ai][bj][m][n];
              s += v.x * v.x + v.y * v.y + v.z * v.z + v.w * v.w;
            }
            s += __shfl_xor(s, 16); s += __shfl_xor(s, 32);
            part[ai][bj][n] = s;
            if (fq == 0) ex[((wid * 2 + ai) * 4 + bj * 2 + n) * 16 + fr] = s;
          }
      __syncthreads();
#pragma unroll
      for (int ai = 0; ai < 2; ++ai) {
        const int head = 2 * (ntile - 4) + ai;
        const int cb = head * 128;
        const float* gp = p.sgu_norm_g + l * 512 + cb;
#pragma unroll
        for (int bj = 0; bj < 2; ++bj)
#pragma unroll
          for (int n = 0; n < 2; ++n) {
            const float r = rs[bj][n];
            const float tot = (part[ai][bj][n] + ex[(((wid ^ 4) * 2 + ai) * 4 + bj * 2 + n) * 16 + fr]) * r * r;
            const float rn = rsqrtf(tot * (1.f / 128.f) + EPS) * r;
            const int tk = tok[bj][n];
#pragma unroll
            for (int m = 0; m < 4; ++m) {
              const int sc0 = sc00 + m * 16;
              const f32x4 v = acc[ai][bj][m][n];
              const f32x4 gg = *(const f32x4*)(gp + sc0);
              const unsigned o0 = pk(v.x * rn * gg.x, v.y * rn * gg.y), o1 = pk(v.z * rn * gg.z, v.w * rn * gg.w);
              if (samp) {
                const int rs_ = tk - TP;
                *(f32x4*)(p.out + OSGU + (size_t)l * 131072 + (size_t)rs_ * 512 + cb + sc0) = v * r;
                u32x2 o; o.x = o0; o.y = o1;
                *(u32x2*)(VNS + (size_t)rs_ * 512 + cb + sc0) = o;
              } else {
                const int b = tk >> 11, tt = tk & 2047;
                ushort_t* vb = VNT + ((size_t)(b * 4 + head) * 128 + sc0) * 2048 + tt;
                vb[0] = (ushort_t)(o0 & 0xffff); vb[2048] = (ushort_t)(o0 >> 16);
                vb[4096] = (ushort_t)(o1 & 0xffff); vb[6144] = (ushort_t)(o1 >> 16);
              }
            }
          }
      }
      __syncthreads();
    } else if (ntile < 10) {
      const int head = ntile - 6, cb = head * 128;
#pragma unroll
      for (int ai = 0; ai < 2; ++ai) {
        const float* gp = (ai == 0 ? p.q_norm_g : p.k_norm_g) + l * 64;
#pragma unroll
        for (int bj = 0; bj < 2; ++bj)
#pragma unroll
          for (int n = 0; n < 2; ++n) {
            float s = 0.f;
#pragma unroll
            for (int m = 0; m < 4; ++m) {
              const f32x4 v = acc[ai][bj][m][n];
              s += v.x * v.x + v.y * v.y + v.z * v.z + v.w * v.w;
            }
            s += __shfl_xor(s, 16); s += __shfl_xor(s, 32);
            const float r = rs[bj][n];
            const float rn = rsqrtf(s * r * r * (1.f / 64.f) + EPS) * r * (ai == 0 ? 0.125f * LOG2E : 1.f);
            const int tk = tok[bj][n];
#pragma unroll
            for (int m = 0; m < 4; ++m) {
              const int sc0 = sc00 + m * 16;
              const f32x4 gg = *(const f32x4*)(gp + fq * 4 + m * 16);
              const f32x4 v = acc[ai][bj][m][n] * rn * gg;
              u32x2 o; o.x = pk(v.x, v.y); o.y = pk(v.z, v.w);
              if (ai == 0) {
                *(u32x2*)(Qb + (size_t)tk * 512 + cb + sc0) = o;
              } else if (samp) {
                const int rs_ = tk - TP, b = rs_ >> 4, tq = rs_ & 15;
                *(f32x4*)(p.out + OKS + (size_t)l * 131072 + (size_t)rs_ * 512 + cb + sc0) = v;
                *(u32x2*)(KSB + ((size_t)(l * 16 + b) * SROWS + 1024 + tq) * 512 + cb + sc0) = o;
              } else {
                *(f32x4*)(p.out + OKP + (size_t)l * 8388608 + (size_t)tk * 512 + cb + sc0) = v;
                *(u32x2*)(Kb + (size_t)tk * 512 + cb + sc0) = o;
              }
            }
          }
      }
    } else {
      const int head = ntile - 10, cb = head * 128;
#pragma unroll
      for (int bj = 0; bj < 2; ++bj)
#pragma unroll
        for (int n = 0; n < 2; ++n) {
          const float r = rs[bj][n];
          const int tk = tok[bj][n];
#pragma unroll
          for (int m = 0; m < 4; ++m) {
            const int sc0 = sc00 + m * 16;
            const f32x4 v = acc[0][bj][m][n] * r;
            const unsigned o0 = pk(v.x, v.y), o1 = pk(v.z, v.w);
            if (samp) {
              const int rs_ = tk - TP, b = rs_ >> 4, tq = rs_ & 15;
              *(f32x4*)(p.out + OVS + (size_t)l * 131072 + (size_t)rs_ * 512 + cb + sc0) = v;
              ushort_t* vb = VTS + ((size_t)((l * 16 + b) * 4 + head) * 128 + sc0) * SROWS + 1024 + kperm(tq);
              vb[0] = (ushort_t)(o0 & 0xffff); vb[SROWS] = (ushort_t)(o0 >> 16);
              vb[2 * SROWS] = (ushort_t)(o1 & 0xffff); vb[3 * SROWS] = (ushort_t)(o1 >> 16);
            } else {
              *(f32x4*)(p.out + OVP + (size_t)l * 8388608 + (size_t)tk * 512 + cb + sc0) = v;
              const int b = tk >> 11, tt = tk & 2047;
              ushort_t* vb = VT + ((size_t)(b * 4 + head) * 128 + sc0) * 2048 + (tt & ~15) + kperm(tt & 15);
              vb[0] = (ushort_t)(o0 & 0xffff); vb[2048] = (ushort_t)(o0 >> 16);
              vb[4096] = (ushort_t)(o1 & 0xffff); vb[6144] = (ushort_t)(o1 >> 16);
            }
            const f32x4 g = acc[1][bj][m][n] * r;
            u32x2 o; o.x = pk(silu(g.x), silu(g.y)); o.y = pk(silu(g.z), silu(g.w));
            *(u32x2*)(GB + (size_t)tk * 512 + cb + sc0) = o;
          }
        }
    }
  }
}

DI void attn_unit(const Params& p, int l, const ushort_t* Kp, const ushort_t* Vp, int vstride, int qrow0, int qpos0,
                  int ntiles, int head, bool sample, char* smem, float lam, float M2, float oscale) {
  int t_ = tidx(p); asm volatile("" : "+v"(t_));
  const int t = t_, lane = t & 63, w = t >> 6, l31 = lane & 31, h = lane >> 5;
  const int rg = sample ? (w >> 1) : (w & 3), hc = sample ? (w & 1) : (w >> 2);
  const ushort_t* Qb = (const ushort_t*)(p.ws + WS_Q);
  const ushort_t* GB = (const ushort_t*)(p.ws + WS_GB);
  ushort_t* Y = (ushort_t*)(p.ws + WS_Y);

  int qrow, qpos, mytiles;
  if (sample) { qrow = qrow0 + (l31 & 15); qpos = qpos0 + (l31 & 15); mytiles = (rg == 0) ? ntiles : 0; }
  else { qrow = qrow0 + rg * 32 + l31; qpos = qpos0 + rg * 32 + l31; mytiles = ntiles - 1 + (rg >> 1); }
  const int diagtile = sample ? 16 : (qpos0 >> 6) + (rg >> 1);
  bf16x8 qf[4];
#pragma unroll
  for (int ks = 0; ks < 4; ++ks) qf[ks] = *(const bf16x8*)(Qb + (size_t)qrow * 512 + head * 128 + hc * 64 + ks * 16 + h * 8);
  const float slope2 = exp2f(-2.f * (float)(head + 1)) * LOG2E;

  f32x16 ot[4];
#pragma unroll
  for (int dt = 0; dt < 4; ++dt)
#pragma unroll
    for (int i = 0; i < 16; ++i) ot[dt][i] = 0.f;
  float lsum = 0.f;

  const unsigned lds0 = (unsigned)(size_t)smem;
  unsigned koff[4], voff[4];
#pragma unroll
  for (int x = 0; x < 4; ++x) {
    koff[x] = (unsigned)(l31 * 256 + (((hc * 8 + x * 2 + h) ^ (l31 & 15)) * 16));
    voff[x] = (unsigned)(l31 * 128 + (((x * 2 + h) ^ ((l31 >> 1) & 7)) * 16));
  }
  unsigned ksrc[2], vsrc[2];
#pragma unroll
  for (int i = 0; i < 2; ++i) {
    const int o = t * 16 + i * 8192;
    const int row = o >> 8, cp = (o >> 4) & 15;
    ksrc[i] = (unsigned)(row * 512 + ((cp ^ (row & 15)) * 8)) * 2u;
    const int d = o >> 7, cv = (o >> 4) & 7;
    vsrc[i] = (unsigned)(d * vstride + ((cv ^ ((d >> 1) & 7)) * 8)) * 2u;
  }
  auto issue = [&](int j) {
    char* slot = smem + (j & 3) * 32768;
#pragma unroll
    for (int i = 0; i < 2; ++i) GLDS((const char*)(Kp + (size_t)j * 64 * 512) + ksrc[i], slot + t * 16 + i * 8192);
#pragma unroll
    for (int i = 0; i < 2; ++i) GLDS((const char*)(Vp + (size_t)j * 64) + vsrc[i], slot + 16384 + t * 16 + i * 8192);
  };
#define VREAD(dst, sl, x) do { const unsigned _a = (sl) + voff[x]; \
    DSR(dst[0], _a, 16384); DSR(dst[1], _a, 20480); DSR(dst[2], _a, 24576); DSR(dst[3], _a, 28672); } while (0)
#define VWAIT(n, v) asm volatile("s_waitcnt lgkmcnt(" #n ")" : "+v"(v[0]), "+v"(v[1]), "+v"(v[2]), "+v"(v[3]))
#define PVMMA(v, s2) do { _Pragma("unroll") for (int dt = 0; dt < 4; ++dt) ot[dt] = MFMA32(v[dt], pf[s2], ot[dt]); } while (0)
#define EXP8(kt, o8) do { _Pragma("unroll") for (int i = (o8); i < (o8) + 8; ++i) { \
    const float pv = __builtin_amdgcn_exp2f(st[kt][i]); lsum += pv; st[kt][i] = pv; } } while (0)

  asm volatile("" : "+v"(qf[0]), "+v"(qf[1]), "+v"(qf[2]), "+v"(qf[3]));
  __syncthreads();
  issue(0);
  if (ntiles > 1) issue(1);
  bf16x8 pf[4];
#pragma unroll
  for (int x = 0; x < 4; ++x) pf[x] = (bf16x8){0, 0, 0, 0, 0, 0, 0, 0};
#pragma unroll 1
  for (int j = 0; j <= ntiles; ++j) {
    if (j + 1 < ntiles) { WAIT_V(4); } else { WAIT_V(0); }
    BAR;
    if (j + 2 < ntiles) issue(j + 2);
    const bool doqk = (j < mytiles), dopv = (j >= 1 && j <= mytiles);
    const unsigned slot = lds0 + (unsigned)(j & 3) * 32768u;
    const unsigned pslot = lds0 + (unsigned)((j + 3) & 3) * 32768u;
    f32x16 st[2];
    bf16x8 va[4], vb[4];
    if (dopv) { VREAD(va, pslot, 0); VREAD(vb, pslot, 1); }
    if (doqk) {
      const int dq = qpos - 64 * j - 4 * h;
      bf16x8 ka[4], kb[4];
      {
        const unsigned a0 = slot + koff[0], a1 = slot + koff[1], a2 = slot + koff[2], a3 = slot + koff[3];
        DSR(ka[0], a0, 0); DSR(ka[1], a0, 8192); DSR(ka[2], a1, 0); DSR(ka[3], a1, 8192);
        DSR(kb[0], a2, 0); DSR(kb[1], a2, 8192); DSR(kb[2], a3, 0); DSR(kb[3], a3, 8192);
      }
      if (j < diagtile) {
        const float base = -slope2 * (float)dq - M2;
        float be[4];
#pragma unroll
        for (int e = 0; e < 4; ++e) be[e] = fmaf(slope2, (float)e, base);
#pragma unroll
        for (int kt = 0; kt < 2; ++kt)
#pragma unroll
          for (int g = 0; g < 4; ++g) {
            const float cs = __int_as_float(__builtin_amdgcn_readfirstlane(__float_as_int(slope2 * (float)(32 * kt + 8 * g))));
#pragma unroll
            for (int e = 0; e < 4; ++e) {
              float r;
              asm("v_add_f32 %0, %1, %2" : "=v"(r) : "s"(cs), "v"(be[e]));
              st[kt][4 * g + e] = r;
            }
          }
      } else {
        const bool lastmask = sample && (j == ntiles - 1);
#pragma unroll
        for (int kt = 0; kt < 2; ++kt)
#pragma unroll
          for (int i = 0; i < 16; ++i) {
            const int off = 32 * kt + 8 * (i >> 2) + (i & 3);
            const int dd = dq - off;
            float bv = -slope2 * (float)(dd < 0 ? -dd : dd) - M2;
            if (lastmask && (kt == 1 || (i >> 2) >= 2)) bv = -1e30f;
            st[kt][i] = bv;
          }
      }
      asm volatile("s_waitcnt lgkmcnt(4)" : "+v"(ka[0]), "+v"(ka[1]), "+v"(ka[2]), "+v"(ka[3]));
      st[0] = MFMA32(ka[0], qf[0], st[0]); st[1] = MFMA32(ka[1], qf[0], st[1]);
      st[0] = MFMA32(ka[2], qf[1], st[0]); st[1] = MFMA32(ka[3], qf[1], st[1]);
      asm volatile("s_waitcnt lgkmcnt(0)" : "+v"(kb[0]), "+v"(kb[1]), "+v"(kb[2]), "+v"(kb[3]));
      st[0] = MFMA32(kb[0], qf[2], st[0]); st[1] = MFMA32(kb[1], qf[2], st[1]);
      st[0] = MFMA32(kb[2], qf[3], st[0]); st[1] = MFMA32(kb[3], qf[3], st[1]);
    }
    if (doqk && dopv) {
      VWAIT(0, va); PVMMA(va, 0); EXP8(0, 0);
      VREAD(va, pslot, 2);
      VWAIT(4, vb); PVMMA(vb, 1); EXP8(0, 8);
      VREAD(vb, pslot, 3);
      VWAIT(4, va); PVMMA(va, 2); EXP8(1, 0);
      VWAIT(0, vb); PVMMA(vb, 3); EXP8(1, 8);
    } else if (doqk) {
      EXP8(0, 0); EXP8(0, 8); EXP8(1, 0); EXP8(1, 8);
    } else if (dopv) {
      VWAIT(4, va); PVMMA(va, 0);
      VREAD(va, pslot, 2);
      VWAIT(4, vb); PVMMA(vb, 1);
      VREAD(vb, pslot, 3);
      VWAIT(4, va); PVMMA(va, 2);
      VWAIT(0, vb); PVMMA(vb, 3);
    }
    if (doqk) {
#pragma unroll
      for (int s2 = 0; s2 < 4; ++s2) {
        const int kt = s2 >> 1, o8 = 8 * (s2 & 1);
        union { u32x4 u; bf16x8 v; } cv;
        cv.u.x = pk(st[kt][o8 + 0], st[kt][o8 + 1]);
        cv.u.y = pk(st[kt][o8 + 2], st[kt][o8 + 3]);
        cv.u.z = pk(st[kt][o8 + 4], st[kt][o8 + 5]);
        cv.u.w = pk(st[kt][o8 + 6], st[kt][o8 + 7]);
        pf[s2] = cv.v;
      }
    }
  }
#undef VREAD
#undef VWAIT
#undef PVMMA
#undef EXP8

  lsum += __shfl_xor(lsum, 32);
  const float inv = 1.f / lsum;
  __syncthreads();
  float* Ol = (float*)smem;
  if (hc == 1) {
    const float sc = lam * inv;
#pragma unroll
    for (int dt = 0; dt < 4; ++dt)
#pragma unroll
      for (int g = 0; g < 4; ++g) {
        const int d0 = 32 * dt + 8 * g + 4 * h;
        f32x4 v = {ot[dt][4 * g] * sc, ot[dt][4 * g + 1] * sc, ot[dt][4 * g + 2] * sc, ot[dt][4 * g + 3] * sc};
        *(f32x4*)(Ol + (rg * 32 + l31) * 132 + d0) = v;
      }
  }
  __syncthreads();
  if (hc == 0) {
    float ssq = 0.f;
#pragma unroll
    for (int dt = 0; dt < 4; ++dt)
#pragma unroll
      for (int g = 0; g < 4; ++g) {
        const int d0 = 32 * dt + 8 * g + 4 * h;
        const f32x4 v2 = *(const f32x4*)(Ol + (rg * 32 + l31) * 132 + d0);
        ot[dt][4 * g + 0] = ot[dt][4 * g + 0] * inv - v2.x;
        ot[dt][4 * g + 1] = ot[dt][4 * g + 1] * inv - v2.y;
        ot[dt][4 * g + 2] = ot[dt][4 * g + 2] * inv - v2.z;
        ot[dt][4 * g + 3] = ot[dt][4 * g + 3] * inv - v2.w;
        ssq += ot[dt][4 * g] * ot[dt][4 * g] + ot[dt][4 * g + 1] * ot[dt][4 * g + 1] + ot[dt][4 * g + 2] * ot[dt][4 * g + 2] +
               ot[dt][4 * g + 3] * ot[dt][4 * g + 3];
      }
    ssq += __shfl_xor(ssq, 32);
    const float rn = rsqrtf(ssq * (1.f / 128.f) + EPS) * oscale;
    const bool valid = sample ? (rg == 0 && l31 < 16) : true;
    const float* sg = p.subln_g + l * 128;
    ushort_t* yrow = Y + (size_t)qrow * 1024 + 512 + head * 128;
    const ushort_t* gbrow = GB + (size_t)qrow * 512 + head * 128;
#pragma unroll
    for (int dt = 0; dt < 4; ++dt)
#pragma unroll
      for (int gp = 0; gp < 2; ++gp) {
        u32x2 og[2];
#pragma unroll
        for (int q = 0; q < 2; ++q) {
          const int g = 2 * gp + q;
          const int d0 = 32 * dt + 8 * g + 4 * h;
          const u32x2 gb = *(const u32x2*)(gbrow + d0);
          const f32x4 gg = *(const f32x4*)(sg + d0);
          og[q].x = pk(ot[dt][4 * g] * rn * gg.x * bflo(gb.x), ot[dt][4 * g + 1] * rn * gg.y * bfhi(gb.x));
          og[q].y = pk(ot[dt][4 * g + 2] * rn * gg.z * bflo(gb.y), ot[dt][4 * g + 3] * rn * gg.w * bfhi(gb.y));
        }
        const u32x2 snd = h ? og[0] : og[1];
        u32x2 rcv;
        rcv.x = (unsigned)__shfl_xor((int)snd.x, 32);
        rcv.y = (unsigned)__shfl_xor((int)snd.y, 32);
        u32x4 o16;
        if (h == 0) { o16.x = og[0].x; o16.y = og[0].y; o16.z = rcv.x; o16.w = rcv.y; }
        else { o16.x = rcv.x; o16.y = rcv.y; o16.z = og[1].x; o16.w = og[1].y; }
        if (valid) *(u32x4*)(yrow + 32 * dt + 16 * gp + 8 * h) = o16;
      }
  }
}

DI void sgu_unit(const Params& p, int l, int b, int n, int head, char* smem) {
  int t_ = tidx(p); asm volatile("" : "+v"(t_));
  const int t = t_, lane = t & 63, w = t >> 6, l31 = lane & 31, h = lane >> 5;
  const int dtile = w & 3, th = w >> 2;
  const ushort_t* UG = (const ushort_t*)(p.ws + WS_UG);
  const ushort_t* VNT = (const ushort_t*)(p.ws + WS_VNT);
  ushort_t* Y = (ushort_t*)(p.ws + WS_Y);
  char* Wl = smem;
  const float* W = p.sgu_w + (size_t)(l * 4 + head) * 128 * 128;
  __syncthreads();
#pragma unroll
  for (int i = 0; i < 4; ++i) {
    const int f = t + 512 * i, row = f >> 4, c8 = f & 15;
    f32x4 a = *(const f32x4*)(W + row * 128 + c8 * 8);
    f32x4 bq = *(const f32x4*)(W + row * 128 + c8 * 8 + 4);
    const int s0 = c8 * 8;
    if (s0 + 0 > row) a.x = 0.f; if (s0 + 1 > row) a.y = 0.f; if (s0 + 2 > row) a.z = 0.f; if (s0 + 3 > row) a.w = 0.f;
    if (s0 + 4 > row) bq.x = 0.f; if (s0 + 5 > row) bq.y = 0.f; if (s0 + 6 > row) bq.z = 0.f; if (s0 + 7 > row) bq.w = 0.f;
    *(u32x4*)(Wl + row * 272 + c8 * 16) = pk8(a, bq);
  }
  bf16x8 af[8];
#pragma unroll
  for (int ks = 0; ks < 8; ++ks)
    af[ks] = *(const bf16x8*)(VNT + ((size_t)(b * 4 + head) * 128 + 32 * dtile + l31) * 2048 + n * 128 + ks * 16 + h * 8);
  __syncthreads();
  f32x16 acc[2];
#pragma unroll
  for (int q = 0; q < 2; ++q) {
#pragma unroll
    for (int i = 0; i < 16; ++i) acc[q][i] = 0.f;
#pragma unroll
    for (int ks = 0; ks < 8; ++ks) {
      if (ks <= 4 * th + 2 * q + 1) {
        const bf16x8 bw = *(const bf16x8*)(Wl + (32 * (2 * th + q) + l31) * 272 + ks * 32 + h * 16);
        acc[q] = MFMA32(af[ks], bw, acc[q]);
      }
    }
  }
#pragma unroll
  for (int q = 0; q < 2; ++q) {
    const int tt = 32 * (2 * th + q) + l31;
    const size_t r = (size_t)b * 2048 + n * 128 + tt;
    const float bias = p.sgu_b[(l * 4 + head) * 128 + tt];
#pragma unroll
    for (int g = 0; g < 4; ++g) {
      const int d0 = 32 * dtile + 8 * g + 4 * h;
      const u32x2 u = *(const u32x2*)(UG + r * 512 + head * 128 + d0);
      u32x2 o;
      o.x = pk((acc[q][4 * g] + bias) * bflo(u.x), (acc[q][4 * g + 1] + bias) * bfhi(u.x));
      o.y = pk((acc[q][4 * g + 2] + bias) * bflo(u.y), (acc[q][4 * g + 3] + bias) * bfhi(u.y));
      *(u32x2*)(Y + r * 1024 + head * 128 + d0) = o;
    }
  }
}

DI void sgu_sample_unit(const Params& p, int l, int b, int head) {
  const int t = tidx(p);
  const ushort_t* UG = (const ushort_t*)(p.ws + WS_UG);
  const ushort_t* VNS = (const ushort_t*)(p.ws + WS_VNS);
  ushort_t* Y = (ushort_t*)(p.ws + WS_Y);
  const float* W = p.sgu_w + (size_t)(l * 4 + head) * 128 * 128;
  for (int idx = t; idx < 2048; idx += 512) {
    const int tt = idx >> 7, d = idx & 127, col = head * 128 + d;
    float wv[16], vv[16];
#pragma unroll
    for (int q = 0; q < 16; ++q) {
      wv[q] = W[tt * 128 + q];
      vv[q] = bflo((unsigned)VNS[(size_t)(b * 16 + q) * 512 + col]);
    }
    float a = p.sgu_b[(l * 4 + head) * 128 + tt];
#pragma unroll
    for (int q = 0; q < 16; ++q) a += (q <= tt) ? wv[q] * vv[q] : 0.f;
    const size_t r = (size_t)TP + b * 16 + tt;
    const float y = a * bflo((unsigned)UG[r * 512 + col]);
    Y[r * 1024 + col] = (ushort_t)(pk(y, y) & 0xffff);
  }
}

DI void phase_mix(const Params& p, int l, char* smem, int* s_item) {
  const float* par = (const float*)(p.ws + WS_PAR);
  const float lam = par[l * 4 + 0], M2 = par[l * 4 + 1], oscale = par[l * 4 + 2];
  const int G = gridDim.x;
  const ushort_t* Kb = (const ushort_t*)(p.ws + WS_K);
  const ushort_t* VT = (const ushort_t*)(p.ws + WS_VT);
  const ushort_t* KSB = (const ushort_t*)(p.ws + WS_KSB);
  const ushort_t* VTS = (const ushort_t*)(p.ws + WS_VTS);
  for (int u0 = blockIdx.x; u0 < 256; u0 += G) {
    const int u = ((G & 7) == 0 && G >= 256) ? ((u0 & 7) * 32 + (u0 >> 3)) : u0;
    const int bh = u >> 3, pi = u & 7, b = bh >> 2, head = bh & 3;
#pragma unroll 1
    for (int half = 0; half < 2; ++half) {
      const int qb = half ? pi : 15 - pi;
      attn_unit(p, l, Kb + (size_t)b * 2048 * 512 + head * 128, VT + (size_t)(b * 4 + head) * 128 * 2048, 2048,
                b * 2048 + qb * 128, qb * 128, 2 * qb + 2, head, false, smem, lam, M2, oscale);
    }
  }
  for (int u = blockIdx.x; u < 64; u += G) {
    const int b = u >> 2, head = u & 3;
    attn_unit(p, l, KSB + (size_t)(l * 16 + b) * SROWS * 512 + head * 128, VTS + (size_t)((l * 16 + b) * 4 + head) * 128 * SROWS,
              SROWS, TP + b * 16, 1024, 17, head, true, smem, lam, M2, oscale);
  }
  unsigned* ctr = (unsigned*)(p.ws + WS_PAR) + 16 + l;
  while (true) {
    __syncthreads();
    if (tidx(p) == 0) *s_item = (int)atomicAdd(ctr, 1u);
    __syncthreads();
    const int item = *s_item;
    if (item >= 576) break;
    if (item < 64) sgu_sample_unit(p, l, item >> 2, item & 3);
    else { const int j = item - 64; sgu_unit(p, l, j >> 6, (j >> 2) & 15, j & 3, smem); }
  }
}

DI void phase_out(const Params& p, int l, char* smem) {
  const ushort_t* Y = (const ushort_t*)(p.ws + WS_Y);
  const ushort_t* Wt = (const ushort_t*)(p.ws + WS_WOUT) + (size_t)l * DM * DM;
  ushort_t* XB = (ushort_t*)(p.ws + WS_XB);
  float* ssq1 = (float*)(p.ws + WS_SSQ) + TT;
  const int G = gridDim.x;
  constexpr int NTILES = 64 * 4;
  for (int id = blockIdx.x; id < NTILES; id += G) {
    const int mt = id >> 2, ntile = id & 3;
    f32x4 acc[2][2][4][2];
    gemm256(Wt + (size_t)ntile * 256 * 1024, Y + (size_t)mt * 256 * 1024, acc, smem, tidx(p));
    int t_ = tidx(p); asm volatile("" : "+v"(t_));
    const int tid = t_, wid = tid >> 6, lane = tid & 63, wr = wid >> 2, wc = wid & 3, fr = lane & 15, fq = lane >> 4;
#pragma unroll
    for (int bj = 0; bj < 2; ++bj)
#pragma unroll
      for (int n = 0; n < 2; ++n) {
        const int tk = mt * 256 + bj * 128 + wc * 32 + n * 16 + fr;
        float* orow = p.out + (size_t)tk * 1024;
        float s = 0.f;
#pragma unroll
        for (int ai = 0; ai < 2; ++ai)
#pragma unroll
          for (int m = 0; m < 4; ++m) {
            const int c0 = ntile * 256 + ai * 128 + wr * 64 + m * 16 + fq * 4;
            const u32x2 xb = *(const u32x2*)(XB + (size_t)tk * 1024 + c0);
            f32x4 xv = {bflo(xb.x), bfhi(xb.x), bflo(xb.y), bfhi(xb.y)};
            xv += acc[ai][bj][m][n];
            if (l == 1) *(f32x4*)(orow + c0) = xv;
            if (l == 0) {
              s += xv.x * xv.x + xv.y * xv.y + xv.z * xv.z + xv.w * xv.w;
              u32x2 o; o.x = pk(xv.x, xv.y); o.y = pk(xv.z, xv.w);
              *(u32x2*)(XB + (size_t)tk * 1024 + c0) = o;
            }
          }
        if (l == 0) {
          s += __shfl_xor(s, 16); s += __shfl_xor(s, 32);
          if (fq == 0) atomicAdd(ssq1 + tk, s);
        }
      }
  }
  for (int it = blockIdx.x; it < 256; it += G) {
    const int tid = tidx(p), wid = tid >> 6, lane = tid & 63, fr = lane & 15, fq = lane >> 4;
    const int sl = it >> 2, tg = it & 3, tt = wid & 3, kh = wid >> 2;
    const int tk = TP + tg * 64 + tt * 16 + fr;
    const ushort_t* wp = Wt + (size_t)(sl * 16 + fr) * 1024 + kh * 512 + fq * 8;
    const ushort_t* yp = Y + (size_t)tk * 1024 + kh * 512 + fq * 8;
    bf16x8 wf[16], yf[16];
#pragma unroll
    for (int q = 0; q < 16; ++q) { wf[q] = *(const bf16x8*)(wp + q * 32); yf[q] = *(const bf16x8*)(yp + q * 32); }
    f32x4 a0 = {0.f, 0.f, 0.f, 0.f};
#pragma unroll
    for (int q = 0; q < 16; ++q) a0 = MFMA16(wf[q], yf[q], a0);
    float* cx = (float*)smem;
    __syncthreads();
    if (kh == 1) *(f32x4*)(cx + (tt * 64 + lane) * 4) = a0;
    __syncthreads();
    if (kh == 0) {
      a0 += *(const f32x4*)(cx + (tt * 64 + lane) * 4);
      const int c0 = sl * 16 + fq * 4;
      const u32x2 xb = *(const u32x2*)(XB + (size_t)tk * 1024 + c0);
      f32x4 xv = {bflo(xb.x), bfhi(xb.x), bflo(xb.y), bfhi(xb.y)};
      xv += a0;
      if (l == 1) *(f32x4*)(p.out + (size_t)tk * 1024 + c0) = xv;
      if (l == 0) {
        float sq = xv.x * xv.x + xv.y * xv.y + xv.z * xv.z + xv.w * xv.w;
        u32x2 o; o.x = pk(xv.x, xv.y); o.y = pk(xv.z, xv.w);
        *(u32x2*)(XB + (size_t)tk * 1024 + c0) = o;
        sq += __shfl_xor(sq, 16); sq += __shfl_xor(sq, 32);
        if (fq == 0) atomicAdd(ssq1 + tk, sq);
      }
    }
  }
}

DI unsigned bar_ld(unsigned* p) { return __hip_atomic_load(p, __ATOMIC_RELAXED, __HIP_MEMORY_SCOPE_AGENT); }
DI unsigned bar_add(unsigned* p, unsigned v) { return __hip_atomic_fetch_add(p, v, __ATOMIC_RELAXED, __HIP_MEMORY_SCOPE_AGENT); }
DI unsigned xcc_id() { return (unsigned)__builtin_amdgcn_s_getreg((3 << 11) | 20) & 0xFu; }

DI void grid_barrier(unsigned* ctr, unsigned target, bool leader) {
  asm volatile("s_waitcnt vmcnt(0)" ::: "memory");
  __syncthreads();
  if (leader) {
    __builtin_amdgcn_fence(__ATOMIC_RELEASE, "agent");
    asm volatile("s_waitcnt vmcnt(0)" ::: "memory");
    bar_add(ctr, 1u);
    while (bar_ld(ctr) < target) __builtin_amdgcn_s_sleep(1);
    __builtin_amdgcn_fence(__ATOMIC_ACQUIRE, "agent");
    asm volatile("s_waitcnt vmcnt(0)" ::: "memory");
  }
  __syncthreads();
}
DI void xcd_barrier(unsigned* bar, unsigned round, const unsigned* s_nxcc, bool leader) {
  asm volatile("s_waitcnt vmcnt(0)" ::: "memory");
  __syncthreads();
  if (leader) {
    const unsigned xcc = xcc_id(), nxcc = *s_nxcc;
    const unsigned mine = bar_ld(bar + 64 + 64 * xcc);
    const unsigned old = bar_add(bar + 1088 + 64 * xcc, 1u);
    if (old + 1u == round * mine) {
      __builtin_amdgcn_fence(__ATOMIC_RELEASE, "agent");
      asm volatile("s_waitcnt vmcnt(0)" ::: "memory");
      bar_add(bar + 2112, 1u);
    }
    while (bar_ld(bar + 2112) < round * nxcc) __builtin_amdgcn_s_sleep(1);
    __builtin_amdgcn_fence(__ATOMIC_ACQUIRE, "agent");
    asm volatile("s_waitcnt vmcnt(0)" ::: "memory");
  }
  __syncthreads();
}

__global__ void __launch_bounds__(512, 1) mega_kernel(Params p0) {
  PW p;
  static_cast<Params&>(p) = p0;
  p.wv = __builtin_amdgcn_readfirstlane((int)(threadIdx.x >> 6));
  const bool leader = (tidx(p) == 0);
  __shared__ __attribute__((aligned(16))) char smem[SMEM_BYTES];
  __shared__ int s_item;
  __shared__ unsigned s_nxcc;
  cg::grid_group grid = cg::this_grid();
  if (p0.ws == nullptr) grid.sync();
  unsigned* bar = (unsigned*)(p.ws + WS_BAR);
  const unsigned G = gridDim.x;
  if (leader) bar_add(bar + 64 + 64 * xcc_id(), 1u);
  phase_prep(p, smem);
  if (leader) {
    unsigned n, tot;
    do {
      n = 0; tot = 0;
      for (int x = 0; x < 16; ++x) { const unsigned c = bar_ld(bar + 64 + 64 * x); tot += c; n += (c != 0u) ? 1u : 0u; }
      if (tot < G) __builtin_amdgcn_s_sleep(1);
    } while (tot < G);
    s_nxcc = n;
  }
  xcd_barrier(bar, 1, &s_nxcc, leader);
#pragma unroll 1
  for (int l = 0; l < 2; ++l) {
    phase_in(p, l, smem);
    xcd_barrier(bar, 3 * l + 2, &s_nxcc, leader);
    phase_mix(p, l, smem, &s_item);
    xcd_barrier(bar, 3 * l + 3, &s_nxcc, leader);
    phase_out(p, l, smem);
    if (l == 0) xcd_barrier(bar, 4, &s_nxcc, leader);
  }
}

extern "C" void kernel_launch(void* const* d_in, const int* in_sizes, int n_in, void* d_out, int out_size, void* d_ws,
                              size_t ws_size, hipStream_t stream) {
  static int grid_blocks = 0;
  if (!grid_blocks) {
    int dev = 0, cus = 0, per_cu = 0;
    (void)hipGetDevice(&dev);
    (void)hipDeviceGetAttribute(&cus, hipDeviceAttributeMultiprocessorCount, dev);
    (void)hipOccupancyMaxActiveBlocksPerMultiprocessor(&per_cu, mega_kernel, 512, 0);
    if (per_cu > 1) per_cu = 1;
    if (per_cu < 1) per_cu = 1;
    grid_blocks = cus * per_cu;
  }
  Params p{};
  p.x_prompt = (const float*)d_in[0]; p.x_sample = (const float*)d_in[1];
  p.cache_k = (const float*)d_in[2]; p.cache_v = (const float*)d_in[3];
  p.norm_g = (const float*)d_in[4]; p.w_in = (const float*)d_in[5];
  p.sgu_norm_g = (const float*)d_in[6]; p.sgu_w = (const float*)d_in[7]; p.sgu_b = (const float*)d_in[8];
  p.q_norm_g = (const float*)d_in[9]; p.k_norm_g = (const float*)d_in[10];
  p.lq1 = (const float*)d_in[11]; p.lk1 = (const float*)d_in[12]; p.lq2 = (const float*)d_in[13]; p.lk2 = (const float*)d_in[14];
  p.subln_g = (const float*)d_in[15]; p.w_out = (const float*)d_in[16];
  p.out = (float*)d_out; p.ws = (char*)d_ws;
  (void)hipMemsetAsync((char*)d_ws + WS_BAR, 0, 16384, stream);
  void* args[] = {&p};
  hipError_t e = hipLaunchCooperativeKernel((void*)mega_kernel, dim3(grid_blocks), dim3(512), args, 0, stream);
  if (e != hipSuccess) fprintf(stderr, "cooperative launch failed: %s (grid %d)\n", hipGetErrorString(e), grid_blocks);
}
```

```cpp
#include <hip/hip_runtime.h>
#include <hip/hip_cooperative_groups.h>
#include <cstdio>
namespace cg = cooperative_groups;

typedef __attribute__((ext_vector_type(8))) short bf16x8;
typedef __attribute__((ext_vector_type(16))) float f32x16;
typedef __attribute__((ext_vector_type(4))) float f32x4;
typedef __bf16 bf16x2_t __attribute__((ext_vector_type(2)));
typedef float f32x2_t __attribute__((ext_vector_type(2)));
typedef unsigned short ushort_t;
typedef unsigned u32x4 __attribute__((ext_vector_type(4)));
typedef unsigned u32x2 __attribute__((ext_vector_type(2)));

#define DI __device__ __forceinline__
#define MFMA32(a, b, c) __builtin_amdgcn_mfma_f32_32x32x16_bf16((a), (b), (c), 0, 0, 0)
#define MFMA16(a, b, c) __builtin_amdgcn_mfma_f32_16x16x32_bf16((a), (b), (c), 0, 0, 0)
#define GLDS(gp, lp) __builtin_amdgcn_global_load_lds((const unsigned*)(gp), (unsigned*)(lp), 16, 0, 0)
#define WAIT_V(n) asm volatile("s_waitcnt vmcnt(" #n ")" ::: "memory")
#define WAIT_L(n) asm volatile("s_waitcnt lgkmcnt(" #n ")" ::: "memory")
#define BAR __builtin_amdgcn_s_barrier()
#define SCHED __builtin_amdgcn_sched_barrier(0)
#define LDS_BARRIER() do { asm volatile("s_waitcnt lgkmcnt(0)" ::: "memory"); __builtin_amdgcn_s_barrier(); asm volatile("" ::: "memory"); } while (0)
#define DSR(dst, addr, imm) asm volatile("ds_read_b128 %0, %1 offset:%2" : "=v"(dst) : "v"(addr), "n"(imm))

constexpr int DM = 1024, NIN = 3584, TP = 16384, TT = 16640;
constexpr int SROWS = 1088;
constexpr float EPS = 1e-6f;
constexpr float LOG2E = 1.4426950408889634f;

constexpr size_t OKP = 17039360, OVP = 33816576, OKS = 50593792, OVS = 50855936, OSGU = 51118080;

constexpr size_t SZ_ACT = (size_t)TT * 512 * 2;
constexpr size_t WS_WIN = 0;
constexpr size_t WS_WOUT = WS_WIN + (size_t)2 * NIN * DM * 2;
constexpr size_t WS_XB = WS_WOUT + (size_t)2 * DM * DM * 2;
constexpr size_t WS_UG = WS_XB + (size_t)TT * 1024 * 2;
constexpr size_t WS_Q = WS_UG + SZ_ACT;
constexpr size_t WS_K = WS_Q + SZ_ACT;
constexpr size_t WS_GB = WS_K + SZ_ACT;
constexpr size_t WS_VNT = WS_GB + SZ_ACT;
constexpr size_t WS_VNS = WS_VNT + (size_t)32 * 128 * 2048 * 2;
constexpr size_t WS_VT = WS_VNS + (size_t)256 * 512 * 2;
constexpr size_t WS_Y = WS_VT + (size_t)32 * 128 * 2048 * 2;
constexpr size_t WS_KSB = WS_Y + (size_t)TT * 1024 * 2;
constexpr size_t WS_VTS = WS_KSB + (size_t)2 * 16 * SROWS * 512 * 2;
constexpr size_t WS_SSQ = WS_VTS + (size_t)2 * 16 * 4 * 128 * SROWS * 2;
constexpr size_t WS_PAR = WS_SSQ + (size_t)2 * TT * 4;
constexpr size_t WS_BAR = WS_PAR + 256;
constexpr size_t WS_END = WS_BAR + 16384;
static_assert(WS_END <= (size_t)256 * 1024 * 1024, "workspace too large");

constexpr int EX_OFF = 131072;
constexpr int RS_OFF = 131072 + 4096;
constexpr int SMEM_BYTES = 131072 + 4096 + 1024 + 64;

struct Params {
  const float* x_prompt; const float* x_sample; const float* cache_k; const float* cache_v;
  const float* norm_g; const float* w_in; const float* sgu_norm_g; const float* sgu_w; const float* sgu_b;
  const float* q_norm_g; const float* k_norm_g; const float* lq1; const float* lk1; const float* lq2; const float* lk2;
  const float* subln_g; const float* w_out;
  float* out; char* ws;
};
struct PW : Params { int wv; };
__device__ __forceinline__ int tidx(const Params& p) {
  int lane;
  asm volatile("v_mbcnt_lo_u32_b32 %0, -1, 0\n\tv_mbcnt_hi_u32_b32 %0, -1, %0" : "=v"(lane));
  return static_cast<const PW&>(p).wv * 64 + lane;
}

DI unsigned pk(float a, float b) {
  f32x2_t v = {a, b};
  bf16x2_t r = __builtin_convertvector(v, bf16x2_t);
  return __builtin_bit_cast(unsigned, r);
}
DI float bflo(unsigned u) { return __uint_as_float(u << 16); }
DI float bfhi(unsigned u) { return __uint_as_float(u & 0xffff0000u); }
DI float silu(float v) { return v * __builtin_amdgcn_rcpf(1.f + __expf(-v)); }
DI u32x4 pk8(f32x4 a, f32x4 b) {
  u32x4 r; r.x = pk(a.x, a.y); r.y = pk(a.z, a.w); r.z = pk(b.x, b.y); r.w = pk(b.z, b.w); return r;
}
DI int kperm(int k16) { return 8 * ((k16 >> 2) & 1) + (k16 & 3) + 4 * (k16 >> 3); }
DI int kinv(int p16) { return 8 * ((p16 & 7) >> 2) + 4 * (p16 >> 3) + (p16 & 3); }

struct TTRegs { f32x4 v[2]; float g[2]; };
DI void tt_load(TTRegs& R, const float* src, size_t sstride, const float* g, int t) {
#pragma unroll
  for (int i = 0; i < 2; ++i) {
    const int f = t + 512 * i, r = f >> 4, c4 = f & 15;
    R.v[i] = *(const f32x4*)(src + (size_t)r * sstride + c4 * 4);
    R.g[i] = g ? g[r] : 1.f;
  }
}
DI void tt_to_lds(const TTRegs& R, float* tile, int t) {
#pragma unroll
  for (int i = 0; i < 2; ++i) {
    const int f = t + 512 * i, r = f >> 4, c4 = f & 15;
    float* tp = tile + r * 65 + c4 * 4;
    tp[0] = R.v[i].x * R.g[i]; tp[1] = R.v[i].y * R.g[i]; tp[2] = R.v[i].z * R.g[i]; tp[3] = R.v[i].w * R.g[i];
  }
}
DI void tt_store(ushort_t* dst, size_t dstride, bool perm, const float* tile, int t) {
  const int c = t >> 3, k8 = t & 7;
  float v[8];
#pragma unroll
  for (int e = 0; e < 8; ++e) {
    const int p = k8 * 8 + e;
    const int r = perm ? ((p & ~15) + kinv(p & 15)) : p;
    v[e] = tile[r * 65 + c];
  }
  u32x4 o; o.x = pk(v[0], v[1]); o.y = pk(v[2], v[3]); o.z = pk(v[4], v[5]); o.w = pk(v[6], v[7]);
  *(u32x4*)(dst + (size_t)c * dstride + k8 * 8) = o;
}

DI int src_section(int sec) {
  const int nt = sec >> 1, ai = sec & 1;
  if (nt < 4) return ai ? 8 + nt : nt;
  if (nt < 6) return 4 + 2 * (nt - 4) + ai;
  if (nt < 10) return ai ? 16 + (nt - 6) : 12 + (nt - 6);
  return ai ? 24 + (nt - 10) : 20 + (nt - 10);
}

DI void phase_prep(const Params& p, char* smem) {
  float* tile = (float*)smem;
  int t_ = tidx(p); asm volatile("" : "+v"(t_));
  const int t = t_, lane = t & 63, w = t >> 6;
  const int G = gridDim.x;
  {
    struct TJob { const float* src; size_t ss; ushort_t* dst; size_t ds; const float* g; bool perm; };
    auto job = [&](int item) {
      TJob J;
      if (item < 2304) {
        const int l = item / 1152;
        int idx = item % 1152;
        if (idx < 896) {
          const int kt = idx / 56, db = idx % 56;
          const int sb = src_section(db >> 1) * 2 + (db & 1);
          J.src = p.w_in + (size_t)l * DM * NIN + (size_t)(kt * 64) * NIN + sb * 64; J.ss = NIN;
          J.dst = (ushort_t*)(p.ws + WS_WIN) + (size_t)l * NIN * DM + (size_t)(db * 64) * DM + kt * 64; J.ds = DM;
          J.g = p.norm_g + l * DM + kt * 64; J.perm = false;
        } else {
          idx -= 896;
          const int kt = idx / 16, nb = idx % 16;
          J.src = p.w_out + (size_t)l * DM * DM + (size_t)(kt * 64) * DM + nb * 64; J.ss = DM;
          J.dst = (ushort_t*)(p.ws + WS_WOUT) + (size_t)l * DM * DM + (size_t)(nb * 64) * DM + kt * 64; J.ds = DM;
          J.g = nullptr; J.perm = false;
        }
      } else {
        const int it = item - 2304;
        const int dh = it & 1, head = (it >> 1) & 3, pt = (it >> 3) & 15, lb = it >> 7;
        J.src = p.cache_v + ((size_t)lb * 1024 + pt * 64) * 512 + head * 128 + dh * 64; J.ss = 512;
        J.dst = (ushort_t*)(p.ws + WS_VTS) + ((size_t)(lb * 4 + head) * 128 + dh * 64) * SROWS + pt * 64; J.ds = SROWS;
        J.g = nullptr; J.perm = true;
      }
      return J;
    };
    constexpr int NJ = 2304 + 4096;
    TTRegs R[4];
    TJob J[4];
    int item = blockIdx.x * 4;
    if (item < NJ) {
#pragma unroll
      for (int u = 0; u < 4; ++u) { J[u] = job(item + u); tt_load(R[u], J[u].src, J[u].ss, J[u].g, t); }
    }
    while (item < NJ) {
      __syncthreads();
#pragma unroll
      for (int u = 0; u < 4; ++u) tt_to_lds(R[u], tile + u * 4160, t);
      __syncthreads();
      TJob Jc[4];
#pragma unroll
      for (int u = 0; u < 4; ++u) Jc[u] = J[u];
      const int nxt = item + G * 4;
      if (nxt < NJ) {
#pragma unroll
        for (int u = 0; u < 4; ++u) { J[u] = job(nxt + u); tt_load(R[u], J[u].src, J[u].ss, J[u].g, t); }
      }
#pragma unroll
      for (int u = 0; u < 4; ++u) tt_store(Jc[u].dst, Jc[u].ds, Jc[u].perm, tile + u * 4160, t);
      item = nxt;
    }
  }
  {
    ushort_t* XB = (ushort_t*)(p.ws + WS_XB);
    float* ssq = (float*)(p.ws + WS_SSQ);
    for (int row0 = (blockIdx.x * 8 + w) * 4; row0 < TT; row0 += G * 32) {
      f32x4 v[4][4];
#pragma unroll
      for (int rr = 0; rr < 4; ++rr) {
        const int row = row0 + rr;
        const float* xr = (row < TP) ? p.x_prompt + (size_t)row * 1024 : p.x_sample + (size_t)(row - TP) * 1024;
#pragma unroll
        for (int i = 0; i < 4; ++i) v[rr][i] = *(const f32x4*)(xr + i * 256 + lane * 4);
      }
#pragma unroll
      for (int rr = 0; rr < 4; ++rr) {
        const int row = row0 + rr;
        float sq = 0.f;
#pragma unroll
        for (int i = 0; i < 4; ++i) {
          const f32x4 a = v[rr][i];
          sq += a.x * a.x + a.y * a.y + a.z * a.z + a.w * a.w;
          u32x2 o; o.x = pk(a.x, a.y); o.y = pk(a.z, a.w);
          *(u32x2*)(XB + (size_t)row * 1024 + i * 256 + lane * 4) = o;
        }
#pragma unroll
        for (int m = 1; m < 64; m <<= 1) sq += __shfl_xor(sq, m);
        if (lane == 0) { ssq[row] = sq; ssq[TT + row] = 0.f; }
      }
    }
  }
  {
    ushort_t* KSB = (ushort_t*)(p.ws + WS_KSB);
    for (int row0 = (blockIdx.x * 8 + w) * 4; row0 < 32768; row0 += G * 32) {
      f32x4 a[4], b4[4];
#pragma unroll
      for (int rr = 0; rr < 4; ++rr) {
        const float* sr = p.cache_k + (size_t)(row0 + rr) * 512 + lane * 8;
        a[rr] = *(const f32x4*)sr; b4[rr] = *(const f32x4*)(sr + 4);
      }
#pragma unroll
      for (int rr = 0; rr < 4; ++rr) {
        const int row = row0 + rr, lb = row >> 10, pos = row & 1023;
        *(u32x4*)(KSB + ((size_t)lb * SROWS + pos) * 512 + lane * 8) = pk8(a[rr], b4[rr]);
      }
    }
  }
  if (blockIdx.x == 0 && w == 0) {
#pragma unroll
    for (int l = 0; l < 2; ++l) {
      float s1 = p.lq1[l * 64 + lane] * p.lk1[l * 64 + lane];
      float s2 = p.lq2[l * 64 + lane] * p.lk2[l * 64 + lane];
      float mq = fabsf(p.q_norm_g[l * 64 + lane]);
      float mk = fabsf(p.k_norm_g[l * 64 + lane]);
#pragma unroll
      for (int m = 1; m < 64; m <<= 1) {
        s1 += __shfl_xor(s1, m); s2 += __shfl_xor(s2, m);
        mq = fmaxf(mq, __shfl_xor(mq, m)); mk = fmaxf(mk, __shfl_xor(mk, m));
      }
      if (lane == 0) {
        const float lam_init = 0.8f - 0.6f * expf(-0.3f * (float)l);
        float* par = (float*)(p.ws + WS_PAR);
        par[l * 4 + 0] = expf(s1) - expf(s2) + lam_init;
        par[l * 4 + 1] = 8.f * mq * mk * 1.03f * LOG2E + 0.25f;
        par[l * 4 + 2] = 1.f - lam_init;
        atomicExch((unsigned*)(p.ws + WS_PAR) + 16 + l, 0u);
      }
    }
  }
}

DI int lds_byte(int r, int c) {
  const int st = (r >> 4) * 2 + (c >> 5), rr = r & 15, cc = c & 31, ob = rr * 64 + cc * 2;
  return st * 1024 + (ob ^ (((ob >> 9) & 1) << 5));
}
DI void stage_rc(int b, int& R, int& C) {
  const int st = b / 1024, sb = b % 1024, swz = sb ^ (((sb >> 9) & 1) << 5);
  R = (st >> 1) * 16 + swz / 64; C = (st & 1) * 32 + (swz % 64) / 2;
}

DI void gemm256(const ushort_t* A, const ushort_t* Bt, f32x4 (&acc)[2][2][4][2], char* shmc, int tid_in) {
  constexpr int K = 1024, BK = 64, HALF = 128, HT = HALF * BK;
  ushort_t* shm = (ushort_t*)shmc;
#define SA(b, h) (shm + ((b) * 2 + (h)) * HT)
#define SB(b, h) (shm + (4 + (b) * 2 + (h)) * HT)
#define STAGE(P, BASE, br, kt) do { const long _g = (long)(br) * K + (long)(kt) * BK; \
    _Pragma("unroll") for (int _i = 0; _i < 2; ++_i) { const int _b = tid * 16 + _i * 8192; int _r, _c; stage_rc(_b, _r, _c); \
      GLDS(BASE + _g + (long)_r * K + _c, (char*)(P) + _b); } } while (0)
#define LDA(dst, b, h) do { const unsigned _a = a_base + ((b) * 2 + (h)) * 16384u; \
    DSR(dst[0][0], _a, 0); DSR(dst[0][1], _a, 1024); DSR(dst[1][0], _a, 2048); DSR(dst[1][1], _a, 3072); \
    DSR(dst[2][0], _a, 4096); DSR(dst[2][1], _a, 5120); DSR(dst[3][0], _a, 6144); DSR(dst[3][1], _a, 7168); } while (0)
#define LDB(dst, b, h) do { const unsigned _a = b_base + (4 + (b) * 2 + (h)) * 16384u; \
    DSR(dst[0][0], _a, 0); DSR(dst[0][1], _a, 1024); DSR(dst[1][0], _a, 2048); DSR(dst[1][1], _a, 3072); } while (0)
#define TIE(Bx) asm volatile("s_waitcnt lgkmcnt(0)" : "+v"(At[0][0]), "+v"(At[0][1]), "+v"(At[1][0]), "+v"(At[1][1]), \
    "+v"(At[2][0]), "+v"(At[2][1]), "+v"(At[3][0]), "+v"(At[3][1]), "+v"(Bx[0][0]), "+v"(Bx[0][1]), "+v"(Bx[1][0]), "+v"(Bx[1][1]))
#define MMA(ai, bj, At_, Bt_) do { __builtin_amdgcn_s_setprio(1); \
    _Pragma("unroll") for (int m = 0; m < 4; ++m) _Pragma("unroll") for (int n = 0; n < 2; ++n) _Pragma("unroll") for (int k = 0; k < 2; ++k) \
      acc[ai][bj][m][n] = MFMA16(At_[m][k], Bt_[n][k], acc[ai][bj][m][n]); \
    __builtin_amdgcn_s_setprio(0); } while (0)

  int tid_ = tid_in; asm volatile("" : "+v"(tid_));
  const int tid = tid_;
  const int wid = tid >> 6, lane = tid & 63, wr = wid >> 2, wc = wid & 3, fr = lane & 15, fq = lane >> 4;
  const unsigned lds0 = (unsigned)(size_t)shmc;
  const unsigned a_base = lds0 + wr * 8192 + lds_byte(fr, fq * 8);
  const unsigned b_base = lds0 + wc * 4096 + lds_byte(fr, fq * 8);
#pragma unroll
  for (int a = 0; a < 2; ++a)
#pragma unroll
    for (int b = 0; b < 2; ++b)
#pragma unroll
      for (int m = 0; m < 4; ++m)
#pragma unroll
        for (int n = 0; n < 2; ++n) acc[a][b][m][n] = (f32x4){0.f, 0.f, 0.f, 0.f};
  bf16x8 At[4][2], B0[2][2], B1[2][2];
  constexpr int nt = K / BK;
  STAGE(SB(0, 0), Bt, 0, 0); STAGE(SA(0, 0), A, 0, 0);
  STAGE(SB(0, 1), Bt, HALF, 0); STAGE(SA(0, 1), A, HALF, 0);
  if (wr == 1) BAR;
  WAIT_V(4); BAR;
  STAGE(SB(1, 0), Bt, 0, 1); STAGE(SA(1, 0), A, 0, 1); STAGE(SB(1, 1), Bt, HALF, 1);
  WAIT_V(6); BAR;
#pragma unroll 1
  for (int t = 0; t < nt - 2; t += 2) {
    LDB(B0, 0, 0); SCHED; LDA(At, 0, 0); STAGE(SA(1, 1), A, HALF, t + 1);
    WAIT_L(8); BAR; TIE(B0); MMA(0, 0, At, B0); BAR; SCHED;
    LDB(B1, 0, 1); STAGE(SB(0, 0), Bt, 0, t + 2);
    BAR; TIE(B1); MMA(0, 1, At, B1); BAR;
    LDA(At, 0, 1); STAGE(SA(0, 0), A, 0, t + 2);
    BAR; TIE(B0); MMA(1, 0, At, B0); BAR; SCHED;
    STAGE(SB(0, 1), Bt, HALF, t + 2);
    WAIT_V(6); BAR; MMA(1, 1, At, B1); BAR;
    LDB(B0, 1, 0); SCHED; LDA(At, 1, 0); STAGE(SA(0, 1), A, HALF, t + 2);
    WAIT_L(8); BAR; TIE(B0); MMA(0, 0, At, B0); BAR; SCHED;
    LDB(B1, 1, 1); STAGE(SB(1, 0), Bt, 0, t + 3);
    BAR; TIE(B1); MMA(0, 1, At, B1); BAR;
    LDA(At, 1, 1); STAGE(SA(1, 0), A, 0, t + 3);
    BAR; TIE(B0); MMA(1, 0, At, B0); BAR; SCHED;
    STAGE(SB(1, 1), Bt, HALF, t + 3);
    WAIT_V(6); BAR; MMA(1, 1, At, B1); BAR;
  }
  { LDB(B0, 0, 0); LDA(At, 0, 0); STAGE(SA(1, 1), A, HALF, nt - 1);
    BAR; TIE(B0); MMA(0, 0, At, B0); BAR;
    LDB(B1, 0, 1); BAR; TIE(B1); MMA(0, 1, At, B1); BAR;
    LDA(At, 0, 1); WAIT_V(4); BAR; TIE(B0); MMA(1, 0, At, B0); MMA(1, 1, At, B1); BAR; }
  { LDB(B0, 1, 0); LDA(At, 1, 0); WAIT_V(2); BAR; TIE(B0); MMA(0, 0, At, B0); BAR;
    LDB(B1, 1, 1); WAIT_V(0); BAR; TIE(B1); MMA(0, 1, At, B1); BAR;
    LDA(At, 1, 1); BAR; TIE(B0); MMA(1, 0, At, B0); MMA(1, 1, At, B1); BAR; }
  if (wr == 0) BAR;
#undef SA
#undef SB
#undef STAGE
#undef LDA
#undef LDB
#undef TIE
#undef MMA
}

DI void phase_in(const Params& p, int l, char* smem) {
  ushort_t* UG = (ushort_t*)(p.ws + WS_UG);
  ushort_t* Qb = (ushort_t*)(p.ws + WS_Q);
  ushort_t* Kb = (ushort_t*)(p.ws + WS_K);
  ushort_t* GB = (ushort_t*)(p.ws + WS_GB);
  ushort_t* VNT = (ushort_t*)(p.ws + WS_VNT);
  ushort_t* VNS = (ushort_t*)(p.ws + WS_VNS);
  ushort_t* VT = (ushort_t*)(p.ws + WS_VT);
  ushort_t* KSB = (ushort_t*)(p.ws + WS_KSB);
  ushort_t* VTS = (ushort_t*)(p.ws + WS_VTS);
  const ushort_t* XB = (const ushort_t*)(p.ws + WS_XB);
  const float* ssq = (const float*)(p.ws + WS_SSQ) + (size_t)l * TT;
  const ushort_t* Wt = (const ushort_t*)(p.ws + WS_WIN) + (size_t)l * NIN * DM;
  float* ex = (float*)(smem + EX_OFF);
  const int G = gridDim.x;
  constexpr int NTILES = 65 * 14;

  for (int id = blockIdx.x; id < NTILES; id += G) {
    int mt, ntile;
    if (id >= 242 && id < 256) { mt = 64; ntile = id - 242; }
    else {
      const int id2 = (id < 242) ? id : id - 14, grp = id2 / (8 * 14), rem = id2 % (8 * 14);
      mt = grp * 8 + (rem & 7); ntile = rem >> 3;
    }
    const float ssq_mine = ssq[mt * 256 + (tidx(p) & 255)];
    f32x4 acc[2][2][4][2];
    gemm256(Wt + (size_t)ntile * 256 * 1024, XB + (size_t)mt * 256 * 1024, acc, smem, tidx(p));

    int t_ = tidx(p); asm volatile("" : "+v"(t_));
    const int tid = t_, wid = tid >> 6, lane = tid & 63, wr = wid >> 2, wc = wid & 3, fr = lane & 15, fq = lane >> 4;
    const bool samp = (mt == 64);
    float* rsl = (float*)(smem + RS_OFF);
    if (tid < 256) rsl[tid] = rsqrtf(ssq_mine * (1.f / 1024.f) + EPS);
    LDS_BARRIER();
    float rs[2][2]; int tok[2][2];
#pragma unroll
    for (int bj = 0; bj < 2; ++bj)
#pragma unroll
      for (int n = 0; n < 2; ++n) {
        const int tl_ = bj * 128 + wc * 32 + n * 16 + fr;
        tok[bj][n] = mt * 256 + tl_;
        rs[bj][n] = rsl[tl_];
      }
    const int sc00 = wr * 64 + fq * 4;

    if (!samp) {
      const int pb = (mt * 256) >> 11, tt0 = (mt * 256) & 2047;
      int tokl[2][2];
#pragma unroll
      for (int bj = 0; bj < 2; ++bj)
#pragma unroll
        for (int n = 0; n < 2; ++n) tokl[bj][n] = bj * 128 + wc * 32 + n * 16 + fr;
      const bool oddl = (fr & 1) != 0;
      auto store_rows = [&](ushort_t* gdst) {
        LDS_BARRIER();
#pragma unroll
        for (int i = 0; i < 8; ++i) {
          const int idx = tid + 512 * i, row = idx >> 4, c = idx & 15;
          const u32x4 v = *(const u32x4*)(smem + row * 272 + c * 16);
          *(u32x4*)(gdst + (size_t)row * 512 + c * 8) = v;
        }
        LDS_BARRIER();
      };
      auto store_tr = [&](ushort_t* gdst) {
        LDS_BARRIER();
#pragma unroll
        for (int i = 0; i < 8; ++i) {
          const int idx = tid + 512 * i, d = idx >> 5, c = idx & 31;
          const u32x4 v = *(const u32x4*)(smem + d * 528 + c * 16);
          *(u32x4*)(gdst + (size_t)d * 2048 + c * 8) = v;
        }
        LDS_BARRIER();
      };
      auto tr_write = [&](int pos, int sc0, unsigned o0, unsigned o1) {
        const unsigned snd = oddl ? o0 : o1;
        const unsigned rcv = (unsigned)__builtin_amdgcn_mov_dpp((int)snd, 0xB1, 0xF, 0xF, true);
        unsigned w0, w1; int d;
        if (!oddl) { w0 = (o0 & 0xffffu) | (rcv << 16); w1 = (o0 >> 16) | (rcv & 0xffff0000u); d = sc0; }
        else { w0 = (rcv & 0xffffu) | (o1 << 16); w1 = (rcv >> 16) | (o1 & 0xffff0000u); d = sc0 + 2; }
        char* ip = smem + d * 528 + (pos >> 1) * 4;
        *(unsigned*)ip = w0; *(unsigned*)(ip + 528) = w1;
      };
      if (ntile < 4) {
        const int cb = ntile * 128;
#pragma unroll
        for (int bj = 0; bj < 2; ++bj)
#pragma unroll
          for (int n = 0; n < 2; ++n) {
            const float r = rs[bj][n];
#pragma unroll
            for (int m = 0; m < 4; ++m) {
              const f32x4 u = acc[0][bj][m][n] * r, g = acc[1][bj][m][n] * r;
              u32x2 o; o.x = pk(u.x * silu(g.x), u.y * silu(g.y)); o.y = pk(u.z * silu(g.z), u.w * silu(g.w));
              *(u32x2*)(smem + tokl[bj][n] * 272 + (sc00 + m * 16) * 2) = o;
            }
          }
        store_rows(UG + (size_t)(mt * 256) * 512 + cb);
      } else if (ntile < 6) {
        float part[2][2][2];
#pragma unroll
        for (int ai = 0; ai < 2; ++ai)
#pragma unroll
          for (int bj = 0; bj < 2; ++bj)
#pragma unroll
            for (int n = 0; n < 2; ++n) {
              float sq = 0.f;
#pragma unroll
              for (int m = 0; m < 4; ++m) {
                const f32x4 v = acc[ai][bj][m][n];
                sq += v.x * v.x + v.y * v.y + v.z * v.z + v.w * v.w;
              }
              sq += __shfl_xor(sq, 16); sq += __shfl_xor(sq, 32);
              part[ai][bj][n] = sq;
              if (fq == 0) ex[((wid * 2 + ai) * 4 + bj * 2 + n) * 16 + fr] = sq;
            }
        __syncthreads();
#pragma unroll
        for (int ai = 0; ai < 2; ++ai) {
          const int head = 2 * (ntile - 4) + ai;
          const float* gp = p.sgu_norm_g + l * 512 + head * 128;
#pragma unroll
          for (int bj = 0; bj < 2; ++bj)
#pragma unroll
            for (int n = 0; n < 2; ++n) {
              const float r = rs[bj][n];
              const float tot = (part[ai][bj][n] + ex[(((wid ^ 4) * 2 + ai) * 4 + bj * 2 + n) * 16 + fr]) * r * r;
              const float rn = rsqrtf(tot * (1.f / 128.f) + EPS) * r;
#pragma unroll
              for (int m = 0; m < 4; ++m) {
                const int sc0 = sc00 + m * 16;
                const f32x4 v = acc[ai][bj][m][n];
                const f32x4 gg = *(const f32x4*)(gp + sc0);
                tr_write(tokl[bj][n], sc0, pk(v.x * rn * gg.x, v.y * rn * gg.y), pk(v.z * rn * gg.z, v.w * rn * gg.w));
              }
            }
          store_tr(VNT + ((size_t)(pb * 4 + head) * 128) * 2048 + tt0);
        }
      } else if (ntile < 10) {
        const int head = ntile - 6, cb = head * 128;
#pragma unroll
        for (int ai = 0; ai < 2; ++ai) {
          const float* gp = (ai == 0 ? p.q_norm_g : p.k_norm_g) + l * 64;
#pragma unroll
          for (int bj = 0; bj < 2; ++bj)
#pragma unroll
            for (int n = 0; n < 2; ++n) {
              float sq = 0.f;
#pragma unroll
              for (int m = 0; m < 4; ++m) {
                const f32x4 v = acc[ai][bj][m][n];
                sq += v.x * v.x + v.y * v.y + v.z * v.z + v.w * v.w;
              }
              sq += __shfl_xor(sq, 16); sq += __shfl_xor(sq, 32);
              const float r = rs[bj][n];
              const float rn = rsqrtf(sq * r * r * (1.f / 64.f) + EPS) * r * (ai == 0 ? 0.125f * LOG2E : 1.f);
              const int tk = tok[bj][n];
#pragma unroll
              for (int m = 0; m < 4; ++m) {
                const int sc0 = sc00 + m * 16;
                const f32x4 gg = *(const f32x4*)(gp + fq * 4 + m * 16);
                const f32x4 v = acc[ai][bj][m][n] * rn * gg;
                u32x2 o; o.x = pk(v.x, v.y); o.y = pk(v.z, v.w);
                if (ai == 1) __builtin_nontemporal_store(v, (f32x4*)(p.out + OKP + (size_t)l * 8388608 + (size_t)tk * 512 + cb + sc0));
                *(u32x2*)(smem + tokl[bj][n] * 272 + sc0 * 2) = o;
              }
            }
          store_rows((ai == 0 ? Qb : Kb) + (size_t)(mt * 256) * 512 + cb);
        }
      } else {
        const int head = ntile - 10, cb = head * 128;
#pragma unroll
        for (int bj = 0; bj < 2; ++bj)
#pragma unroll
          for (int n = 0; n < 2; ++n) {
            const float r = rs[bj][n];
            const int tk = tok[bj][n];
            const int tl = tokl[bj][n];
            const int pos = (tl & ~15) + kperm(tl & 15);
#pragma unroll
            for (int m = 0; m < 4; ++m) {
              const int sc0 = sc00 + m * 16;
              const f32x4 v = acc[0][bj][m][n] * r;
              __builtin_nontemporal_store(v, (f32x4*)(p.out + OVP + (size_t)l * 8388608 + (size_t)tk * 512 + cb + sc0));
              tr_write(pos, sc0, pk(v.x, v.y), pk(v.z, v.w));
            }
          }
        store_tr(VT + ((size_t)(pb * 4 + head) * 128) * 2048 + tt0);
#pragma unroll
        for (int bj = 0; bj < 2; ++bj)
#pragma unroll
          for (int n = 0; n < 2; ++n) {
            const float r = rs[bj][n];
#pragma unroll
            for (int m = 0; m < 4; ++m) {
              const f32x4 g = acc[1][bj][m][n] * r;
              u32x2 o; o.x = pk(silu(g.x), silu(g.y)); o.y = pk(silu(g.z), silu(g.w));
              *(u32x2*)(smem + tokl[bj][n] * 272 + (sc00 + m * 16) * 2) = o;
            }
          }
        store_rows(GB + (size_t)(mt * 256) * 512 + cb);
      }
      continue;
    }
    if (ntile < 4) {
      const int cb = ntile * 128;
#pragma unroll
      for (int bj = 0; bj < 2; ++bj)
#pragma unroll
        for (int n = 0; n < 2; ++n) {
          const float r = rs[bj][n];
#pragma unroll
          for (int m = 0; m < 4; ++m) {
            const f32x4 u = acc[0][bj][m][n] * r, g = acc[1][bj][m][n] * r;
            u32x2 o; o.x = pk(u.x * silu(g.x), u.y * silu(g.y)); o.y = pk(u.z * silu(g.z), u.w * silu(g.w));
            *(u32x2*)(UG + (size_t)tok[bj][n] * 512 + cb + sc00 + m * 16) = o;
          }
        }
    } else if (ntile < 6) {
      float part[2][2][2];
#pragma unroll
      for (int ai = 0; ai < 2; ++ai)
#pragma unroll
        for (int bj = 0; bj < 2; ++bj)
#pragma unroll
          for (int n = 0; n < 2; ++n) {
            float s = 0.f;
#pragma unroll
            for (int m = 0; m < 4; ++m) {
              const f32x4 v = acc[ai][bj][m][n];
              s += v.x * v.x + v.y * v.y + v.z * v.z + v.w * v.w;
            }
            s += __shfl_xor(s, 16); s += __shfl_xor(s, 32);
            part[ai][bj][n] = s;
            if (fq == 0) ex[((wid * 2 + ai) * 4 + bj * 2 + n) * 16 + fr] = s;
          }
      __syncthreads();
#pragma unroll
      for (int ai = 0; ai < 2; ++ai) {
        const int head = 2 * (ntile - 4) + ai;
        const int cb = head * 128;
        const float* gp = p.sgu_norm_g + l * 512 + cb;
#pragma unroll
        for (int bj = 0; bj < 2; ++bj)
#pragma unroll
          for (int n = 0; n < 2; ++n) {
            const float r = rs[bj][n];
            const float tot = (part[ai][bj][n] + ex[(((wid ^ 4) * 2 + ai) * 4 + bj * 2 + n) * 16 + fr]) * r * r;
            const float rn = rsqrtf(tot * (1.f / 128.f) + EPS) * r;
            const int tk = tok[bj][n];
#pragma unroll
            for (int m = 0; m < 4; ++m) {
              const int sc0 = sc00 + m * 16;
              const f32x4 v = acc[ai][bj][m][n];
              const f32x4 gg = *(const f32x4*)(gp + sc0);
              const unsigned o0 = pk(v.x * rn * gg.x, v.y * rn * gg.y), o1 = pk(v.z * rn * gg.z, v.w * rn * gg.w);
              if (samp) {
                const int rs_ = tk - TP;
                *(f32x4*)(p.out + OSGU + (size_t)l * 131072 + (size_t)rs_ * 512 + cb + sc0) = v * r;
                u32x2 o; o.x = o0; o.y = o1;
                *(u32x2*)(VNS + (size_t)rs_ * 512 + cb + sc0) = o;
              } else {
                const int b = tk >> 11, tt = tk & 2047;
                ushort_t* vb = VNT + ((size_t)(b * 4 + head) * 128 + sc0) * 2048 + tt;
                vb[0] = (ushort_t)(o0 & 0xffff); vb[2048] = (ushort_t)(o0 >> 16);
                vb[4096] = (ushort_t)(o1 & 0xffff); vb[6144] = (ushort_t)(o1 >> 16);
              }
            }
          }
      }
      __syncthreads();
    } else if (ntile < 10) {
      const int head = ntile - 6, cb = head * 128;
#pragma unroll
      for (int ai = 0; ai < 2; ++ai) {
        const float* gp = (ai == 0 ? p.q_norm_g : p.k_norm_g) + l * 64;
#pragma unroll
        for (int bj = 0; bj < 2; ++bj)
#pragma unroll
          for (int n = 0; n < 2; ++n) {
            float s = 0.f;
#pragma unroll
            for (int m = 0; m < 4; ++m) {
              const f32x4 v = acc[ai][bj][m][n];
              s += v.x * v.x + v.y * v.y + v.z * v.z + v.w * v.w;
            }
            s += __shfl_xor(s, 16); s += __shfl_xor(s, 32);
            const float r = rs[bj][n];
            const float rn = rsqrtf(s * r * r * (1.f / 64.f) + EPS) * r * (ai == 0 ? 0.125f * LOG2E : 1.f);
            const int tk = tok[bj][n];
#pragma unroll
            for (int m = 0; m < 4; ++m) {
              const int sc0 = sc00 + m * 16;
              const f32x4 gg = *(const f32x4*)(gp + fq * 4 + m * 16);
              const f32x4 v = acc[ai][bj][m][n] * rn * gg;
              u32x2 o; o.x = pk(v.x, v.y); o.y = pk(v.z, v.w);
              if (ai == 0) {
                *(u32x2*)(Qb + (size_t)tk * 512 + cb + sc0) = o;
              } else if (samp) {
                const int rs_ = tk - TP, b = rs_ >> 4, tq = rs_ & 15;
                *(f32x4*)(p.out + OKS + (size_t)l * 131072 + (size_t)rs_ * 512 + cb + sc0) = v;
                *(u32x2*)(KSB + ((size_t)(l * 16 + b) * SROWS + 1024 + tq) * 512 + cb + sc0) = o;
              } else {
                *(f32x4*)(p.out + OKP + (size_t)l * 8388608 + (size_t)tk * 512 + cb + sc0) = v;
                *(u32x2*)(Kb + (size_t)tk * 512 + cb + sc0) = o;
              }
            }
          }
      }
    } else {
      const int head = ntile - 10, cb = head * 128;
#pragma unroll
      for (int bj = 0; bj < 2; ++bj)
#pragma unroll
        for (int n = 0; n < 2; ++n) {
          const float r = rs[bj][n];
          const int tk = tok[bj][n];
#pragma unroll
          for (int m = 0; m < 4; ++m) {
            const int sc0 = sc00 + m * 16;
            const f32x4 v = acc[0][bj][m][n] * r;
            const unsigned o0 = pk(v.x, v.y), o1 = pk(v.z, v.w);
            if (samp) {
              const int rs_ = tk - TP, b = rs_ >> 4, tq = rs_ & 15;
              *(f32x4*)(p.out + OVS + (size_t)l * 131072 + (size_t)rs_ * 512 + cb + sc0) = v;
              ushort_t* vb = VTS + ((size_t)((l * 16 + b) * 4 + head) * 128 + sc0) * SROWS + 1024 + kperm(tq);
              vb[0] = (ushort_t)(o0 & 0xffff); vb[SROWS] = (ushort_t)(o0 >> 16);
              vb[2 * SROWS] = (ushort_t)(o1 & 0xffff); vb[3 * SROWS] = (ushort_t)(o1 >> 16);
            } else {
              *(f32x4*)(p.out + OVP + (size_t)l * 8388608 + (size_t)tk * 512 + cb + sc0) = v;
              const int b = tk >> 11, tt = tk & 2047;
              ushort_t* vb = VT + ((size_t)(b * 4 + head) * 128 + sc0) * 2048 + (tt & ~15) + kperm(tt & 15);
              vb[0] = (ushort_t)(o0 & 0xffff); vb[2048] = (ushort_t)(o0 >> 16);
              vb[4096] = (ushort_t)(o1 & 0xffff); vb[6144] = (ushort_t)(o1 >> 16);
            }
            const f32x4 g = acc[1][bj][m][n] * r;
            u32x2 o; o.x = pk(silu(g.x), silu(g.y)); o.y = pk(silu(g.z), silu(g.w));
            *(u32x2*)(GB + (size_t)tk * 512 + cb + sc0) = o;
          }
        }
    }
  }
}

DI void attn_unit(const Params& p, int l, const ushort_t* Kp, const ushort_t* Vp, int vstride, int qrow0, int qpos0,
                  int ntiles, int head, bool sample, char* smem, float lam, float M2, float oscale) {
  int t_ = tidx(p); asm volatile("" : "+v"(t_));
  const int t = t_, lane = t & 63, w = t >> 6, l31 = lane & 31, h = lane >> 5;
  const int rg = sample ? (w >> 1) : (w & 3), hc = sample ? (w & 1) : (w >> 2);
  const ushort_t* Qb = (const ushort_t*)(p.ws + WS_Q);
  const ushort_t* GB = (const ushort_t*)(p.ws + WS_GB);
  ushort_t* Y = (ushort_t*)(p.ws + WS_Y);

  int qrow, qpos, mytiles;
  if (sample) { qrow = qrow0 + (l31 & 15); qpos = qpos0 + (l31 & 15); mytiles = (rg == 0) ? ntiles : 0; }
  else { qrow = qrow0 + rg * 32 + l31; qpos = qpos0 + rg * 32 + l31; mytiles = ntiles - 1 + (rg >> 1); }
  const int diagtile = sample ? 16 : (qpos0 >> 6) + (rg >> 1);
  bf16x8 qf[4];
#pragma unroll
  for (int ks = 0; ks < 4; ++ks) qf[ks] = *(const bf16x8*)(Qb + (size_t)qrow * 512 + head * 128 + hc * 64 + ks * 16 + h * 8);
  const float slope2 = exp2f(-2.f * (float)(head + 1)) * LOG2E;

  f32x16 ot[4];
#pragma unroll
  for (int dt = 0; dt < 4; ++dt)
#pragma unroll
    for (int i = 0; i < 16; ++i) ot[dt][i] = 0.f;
  float lsum = 0.f;

  const unsigned lds0 = (unsigned)(size_t)smem;
  unsigned koff[4], voff[4];
#pragma unroll
  for (int x = 0; x < 4; ++x) {
    koff[x] = (unsigned)(l31 * 256 + (((hc * 8 + x * 2 + h) ^ (l31 & 15)) * 16));
    voff[x] = (unsigned)(l31 * 128 + (((x * 2 + h) ^ ((l31 >> 1) & 7)) * 16));
  }
  unsigned ksrc[2], vsrc[2];
#pragma unroll
  for (int i = 0; i < 2; ++i) {
    const int o = t * 16 + i * 8192;
    const int row = o >> 8, cp = (o >> 4) & 15;
    ksrc[i] = (unsigned)(row * 512 + ((cp ^ (row & 15)) * 8)) * 2u;
    const int d = o >> 7, cv = (o >> 4) & 7;
    vsrc[i] = (unsigned)(d * vstride + ((cv ^ ((d >> 1) & 7)) * 8)) * 2u;
  }
  auto issue = [&](int j) {
    char* slot = smem + (j & 3) * 32768;
#pragma unroll
    for (int i = 0; i < 2; ++i) GLDS((const char*)(Kp + (size_t)j * 64 * 512) + ksrc[i], slot + t * 16 + i * 8192);
#pragma unroll
    for (int i = 0; i < 2; ++i) GLDS((const char*)(Vp + (size_t)j * 64) + vsrc[i], slot + 16384 + t * 16 + i * 8192);
  };
#define VREAD(dst, sl, x) do { const unsigned _a = (sl) + voff[x]; \
    DSR(dst[0], _a, 16384); DSR(dst[1], _a, 20480); DSR(dst[2], _a, 24576); DSR(dst[3], _a, 28672); } while (0)
#define VWAIT(n, v) asm volatile("s_waitcnt lgkmcnt(" #n ")" : "+v"(v[0]), "+v"(v[1]), "+v"(v[2]), "+v"(v[3]))
#define PVMMA(v, s2) do { _Pragma("unroll") for (int dt = 0; dt < 4; ++dt) ot[dt] = MFMA32(v[dt], pf[s2], ot[dt]); } while (0)
#define EXP8(kt, o8) do { _Pragma("unroll") for (int i = (o8); i < (o8) + 8; ++i) { \
    const float pv = __builtin_amdgcn_exp2f(st[kt][i]); lsum += pv; st[kt][i] = pv; } } while (0)

  asm volatile("" : "+v"(qf[0]), "+v"(qf[1]), "+v"(qf[2]), "+v"(qf[3]));
  __syncthreads();
  issue(0);
  if (ntiles > 1) issue(1);
  bf16x8 pf[4];
#pragma unroll
  for (int x = 0; x < 4; ++x) pf[x] = (bf16x8){0, 0, 0, 0, 0, 0, 0, 0};
#pragma unroll 1
  for (int j = 0; j <= ntiles; ++j) {
    if (j + 1 < ntiles) { WAIT_V(4); } else { WAIT_V(0); }
    BAR;
    if (j + 2 < ntiles) issue(j + 2);
    const bool doqk = (j < mytiles), dopv = (j >= 1 && j <= mytiles);
    const unsigned slot = lds0 + (unsigned)(j & 3) * 32768u;
    const unsigned pslot = lds0 + (unsigned)((j + 3) & 3) * 32768u;
    f32x16 st[2];
    bf16x8 va[4], vb[4];
    if (dopv) { VREAD(va, pslot, 0); VREAD(vb, pslot, 1); }
    if (doqk) {
      const int dq = qpos - 64 * j - 4 * h;
      bf16x8 ka[4], kb[4];
      {
        const unsigned a0 = slot + koff[0], a1 = slot + koff[1], a2 = slot + koff[2], a3 = slot + koff[3];
        DSR(ka[0], a0, 0); DSR(ka[1], a0, 8192); DSR(ka[2], a1, 0); DSR(ka[3], a1, 8192);
        DSR(kb[0], a2, 0); DSR(kb[1], a2, 8192); DSR(kb[2], a3, 0); DSR(kb[3], a3, 8192);
      }
      if (j < diagtile) {
        const float base = -slope2 * (float)dq - M2;
        float be[4];
#pragma unroll
        for (int e = 0; e < 4; ++e) be[e] = fmaf(slope2, (float)e, base);
#pragma unroll
        for (int kt = 0; kt < 2; ++kt)
#pragma unroll
          for (int g = 0; g < 4; ++g) {
            const float cs = __int_as_float(__builtin_amdgcn_readfirstlane(__float_as_int(slope2 * (float)(32 * kt + 8 * g))));
#pragma unroll
            for (int e = 0; e < 4; ++e) {
              float r;
              asm("v_add_f32 %0, %1, %2" : "=v"(r) : "s"(cs), "v"(be[e]));
              st[kt][4 * g + e] = r;
            }
          }
      } else {
        const bool lastmask = sample && (j == ntiles - 1);
#pragma unroll
        for (int kt = 0; kt < 2; ++kt)
#pragma unroll
          for (int i = 0; i < 16; ++i) {
            const int off = 32 * kt + 8 * (i >> 2) + (i & 3);
            const int dd = dq - off;
            float bv = -slope2 * (float)(dd < 0 ? -dd : dd) - M2;
            if (lastmask && (kt == 1 || (i >> 2) >= 2)) bv = -1e30f;
            st[kt][i] = bv;
          }
      }
      asm volatile("s_waitcnt lgkmcnt(4)" : "+v"(ka[0]), "+v"(ka[1]), "+v"(ka[2]), "+v"(ka[3]));
      st[0] = MFMA32(ka[0], qf[0], st[0]); st[1] = MFMA32(ka[1], qf[0], st[1]);
      st[0] = MFMA32(ka[2], qf[1], st[0]); st[1] = MFMA32(ka[3], qf[1], st[1]);
      asm volatile("s_waitcnt lgkmcnt(0)" : "+v"(kb[0]), "+v"(kb[1]), "+v"(kb[2]), "+v"(kb[3]));
      st[0] = MFMA32(kb[0], qf[2], st[0]); st[1] = MFMA32(kb[1], qf[2], st[1]);
      st[0] = MFMA32(kb[2], qf[3], st[0]); st[1] = MFMA32(kb[3], qf[3], st[1]);
    }
    if (doqk && dopv) {
      VWAIT(0, va); PVMMA(va, 0); EXP8(0, 0);
      VREAD(va, pslot, 2);
      VWAIT(4, vb); PVMMA(vb, 1); EXP8(0, 8);
      VREAD(vb, pslot, 3);
      VWAIT(4, va); PVMMA(va, 2); EXP8(1, 0);
      VWAIT(0, vb); PVMMA(vb, 3); EXP8(1, 8);
    } else if (doqk) {
      EXP8(0, 0); EXP8(0, 8); EXP8(1, 0); EXP8(1, 8);
    } else if (dopv) {
      VWAIT(4, va); PVMMA(va, 0);
      VREAD(va, pslot, 2);
      VWAIT(4, vb); PVMMA(vb, 1);
      VREAD(vb, pslot, 3);
      VWAIT(4, va); PVMMA(va, 2);
      VWAIT(0, vb); PVMMA(vb, 3);
    }
    if (doqk) {
#pragma unroll
      for (int s2 = 0; s2 < 4; ++s2) {
        const int kt = s2 >> 1, o8 = 8 * (s2 & 1);
        union { u32x4 u; bf16x8 v; } cv;
        cv.u.x = pk(st[kt][o8 + 0], st[kt][o8 + 1]);
        cv.u.y = pk(st[kt][o8 + 2], st[kt][o8 + 3]);
        cv.u.z = pk(st[kt][o8 + 4], st[kt][o8 + 5]);
        cv.u.w = pk(st[kt][o8 + 6], st[kt][o8 + 7]);
        pf[s2] = cv.v;
      }
    }
  }
#undef VREAD
#undef VWAIT
#undef PVMMA
#undef EXP8

  lsum += __shfl_xor(lsum, 32);
  const float inv = 1.f / lsum;
  __syncthreads();
  float* Ol = (float*)smem;
  if (hc == 1) {
    const float sc = lam * inv;
#pragma unroll
    for (int dt = 0; dt < 4; ++dt)
#pragma unroll
      for (int g = 0; g < 4; ++g) {
        const int d0 = 32 * dt + 8 * g + 4 * h;
        f32x4 v = {ot[dt][4 * g] * sc, ot[dt][4 * g + 1] * sc, ot[dt][4 * g + 2] * sc, ot[dt][4 * g + 3] * sc};
        *(f32x4*)(Ol + (rg * 32 + l31) * 132 + d0) = v;
      }
  }
  __syncthreads();
  if (hc == 0) {
    float ssq = 0.f;
#pragma unroll
    for (int dt = 0; dt < 4; ++dt)
#pragma unroll
      for (int g = 0; g < 4; ++g) {
        const int d0 = 32 * dt + 8 * g + 4 * h;
        const f32x4 v2 = *(const f32x4*)(Ol + (rg * 32 + l31) * 132 + d0);
        ot[dt][4 * g + 0] = ot[dt][4 * g + 0] * inv - v2.x;
        ot[dt][4 * g + 1] = ot[dt][4 * g + 1] * inv - v2.y;
        ot[dt][4 * g + 2] = ot[dt][4 * g + 2] * inv - v2.z;
        ot[dt][4 * g + 3] = ot[dt][4 * g + 3] * inv - v2.w;
        ssq += ot[dt][4 * g] * ot[dt][4 * g] + ot[dt][4 * g + 1] * ot[dt][4 * g + 1] + ot[dt][4 * g + 2] * ot[dt][4 * g + 2] +
               ot[dt][4 * g + 3] * ot[dt][4 * g + 3];
      }
    ssq += __shfl_xor(ssq, 32);
    const float rn = rsqrtf(ssq * (1.f / 128.f) + EPS) * oscale;
    const bool valid = sample ? (rg == 0 && l31 < 16) : true;
    const float* sg = p.subln_g + l * 128;
    ushort_t* yrow = Y + (size_t)qrow * 1024 + 512 + head * 128;
    const ushort_t* gbrow = GB + (size_t)qrow * 512 + head * 128;
#pragma unroll
    for (int dt = 0; dt < 4; ++dt)
#pragma unroll
      for (int gp = 0; gp < 2; ++gp) {
        u32x2 og[2];
#pragma unroll
        for (int q = 0; q < 2; ++q) {
          const int g = 2 * gp + q;
          const int d0 = 32 * dt + 8 * g + 4 * h;
          const u32x2 gb = *(const u32x2*)(gbrow + d0);
          const f32x4 gg = *(const f32x4*)(sg + d0);
          og[q].x = pk(ot[dt][4 * g] * rn * gg.x * bflo(gb.x), ot[dt][4 * g + 1] * rn * gg.y * bfhi(gb.x));
          og[q].y = pk(ot[dt][4 * g + 2] * rn * gg.z * bflo(gb.y), ot[dt][4 * g + 3] * rn * gg.w * bfhi(gb.y));
        }
        const u32x2 snd = h ? og[0] : og[1];
        u32x2 rcv;
        rcv.x = (unsigned)__shfl_xor((int)snd.x, 32);
        rcv.y = (unsigned)__shfl_xor((int)snd.y, 32);
        u32x4 o16;
        if (h == 0) { o16.x = og[0].x; o16.y = og[0].y; o16.z = rcv.x; o16.w = rcv.y; }
        else { o16.x = rcv.x; o16.y = rcv.y; o16.z = og[1].x; o16.w = og[1].y; }
        if (valid) *(u32x4*)(yrow + 32 * dt + 16 * gp + 8 * h) = o16;
      }
  }
}

DI void sgu_unit(const Params& p, int l, int b, int n, int head, char* smem) {
  int t_ = tidx(p); asm volatile("" : "+v"(t_));
  const int t = t_, lane = t & 63, w = t >> 6, l31 = lane & 31, h = lane >> 5;
  const int dtile = w & 3, th = w >> 2;
  const ushort_t* UG = (const ushort_t*)(p.ws + WS_UG);
  const ushort_t* VNT = (const ushort_t*)(p.ws + WS_VNT);
  ushort_t* Y = (ushort_t*)(p.ws + WS_Y);
  char* Wl = smem;
  const float* W = p.sgu_w + (size_t)(l * 4 + head) * 128 * 128;
  __syncthreads();
#pragma unroll
  for (int i = 0; i < 4; ++i) {
    const int f = t + 512 * i, row = f >> 4, c8 = f & 15;
    f32x4 a = *(const f32x4*)(W + row * 128 + c8 * 8);
    f32x4 bq = *(const f32x4*)(W + row * 128 + c8 * 8 + 4);
    const int s0 = c8 * 8;
    if (s0 + 0 > row) a.x = 0.f; if (s0 + 1 > row) a.y = 0.f; if (s0 + 2 > row) a.z = 0.f; if (s0 + 3 > row) a.w = 0.f;
    if (s0 + 4 > row) bq.x = 0.f; if (s0 + 5 > row) bq.y = 0.f; if (s0 + 6 > row) bq.z = 0.f; if (s0 + 7 > row) bq.w = 0.f;
    *(u32x4*)(Wl + row * 272 + c8 * 16) = pk8(a, bq);
  }
  bf16x8 af[8];
#pragma unroll
  for (int ks = 0; ks < 8; ++ks)
    af[ks] = *(const bf16x8*)(VNT + ((size_t)(b * 4 + head) * 128 + 32 * dtile + l31) * 2048 + n * 128 + ks * 16 + h * 8);
  __syncthreads();
  f32x16 acc[2];
#pragma unroll
  for (int q = 0; q < 2; ++q) {
#pragma unroll
    for (int i = 0; i < 16; ++i) acc[q][i] = 0.f;
#pragma unroll
    for (int ks = 0; ks < 8; ++ks) {
      if (ks <= 4 * th + 2 * q + 1) {
        const bf16x8 bw = *(const bf16x8*)(Wl + (32 * (2 * th + q) + l31) * 272 + ks * 32 + h * 16);
        acc[q] = MFMA32(af[ks], bw, acc[q]);
      }
    }
  }
#pragma unroll
  for (int q = 0; q < 2; ++q) {
    const int tt = 32 * (2 * th + q) + l31;
    const size_t r = (size_t)b * 2048 + n * 128 + tt;
    const float bias = p.sgu_b[(l * 4 + head) * 128 + tt];
#pragma unroll
    for (int g = 0; g < 4; ++g) {
      const int d0 = 32 * dtile + 8 * g + 4 * h;
      const u32x2 u = *(const u32x2*)(UG + r * 512 + head * 128 + d0);
      u32x2 o;
      o.x = pk((acc[q][4 * g] + bias) * bflo(u.x), (acc[q][4 * g + 1] + bias) * bfhi(u.x));
      o.y = pk((acc[q][4 * g + 2] + bias) * bflo(u.y), (acc[q][4 * g + 3] + bias) * bfhi(u.y));
      *(u32x2*)(Y + r * 1024 + head * 128 + d0) = o;
    }
  }
}

DI void sgu_sample_unit(const Params& p, int l, int b, int head) {
  const int t = tidx(p);
  const ushort_t* UG = (const ushort_t*)(p.ws + WS_UG);
  const ushort_t* VNS = (const ushort_t*)(p.ws + WS_VNS);
  ushort_t* Y = (ushort_t*)(p.ws + WS_Y);
  const float* W = p.sgu_w + (size_t)(l * 4 + head) * 128 * 128;
  for (int idx = t; idx < 2048; idx += 512) {
    const int tt = idx >> 7, d = idx & 127, col = head * 128 + d;
    float wv[16], vv[16];
#pragma unroll
    for (int q = 0; q < 16; ++q) {
      wv[q] = W[tt * 128 + q];
      vv[q] = bflo((unsigned)VNS[(size_t)(b * 16 + q) * 512 + col]);
    }
    float a = p.sgu_b[(l * 4 + head) * 128 + tt];
#pragma unroll
    for (int q = 0; q < 16; ++q) a += (q <= tt) ? wv[q] * vv[q] : 0.f;
    const size_t r = (size_t)TP + b * 16 + tt;
    const float y = a * bflo((unsigned)UG[r * 512 + col]);
    Y[r * 1024 + col] = (ushort_t)(pk(y, y) & 0xffff);
  }
}

DI void phase_mix(const Params& p, int l, char* smem, int* s_item) {
  const float* par = (const float*)(p.ws + WS_PAR);
  const float lam = par[l * 4 + 0], M2 = par[l * 4 + 1], oscale = par[l * 4 + 2];
  const int G = gridDim.x;
  const ushort_t* Kb = (const ushort_t*)(p.ws + WS_K);
  const ushort_t* VT = (const ushort_t*)(p.ws + WS_VT);
  const ushort_t* KSB = (const ushort_t*)(p.ws + WS_KSB);
  const ushort_t* VTS = (const ushort_t*)(p.ws + WS_VTS);
  for (int u0 = blockIdx.x; u0 < 256; u0 += G) {
    const int u = ((G & 7) == 0 && G >= 256) ? ((u0 & 7) * 32 + (u0 >> 3)) : u0;
    const int bh = u >> 3, pi = u & 7, b = bh >> 2, head = bh & 3;
#pragma unroll 1
    for (int half = 0; half < 2; ++half) {
      const int qb = half ? pi : 15 - pi;
      attn_unit(p, l, Kb + (size_t)b * 2048 * 512 + head * 128, VT + (size_t)(b * 4 + head) * 128 * 2048, 2048,
                b * 2048 + qb * 128, qb * 128, 2 * qb + 2, head, false, smem, lam, M2, oscale);
    }
  }
  for (int u = blockIdx.x; u < 64; u += G) {
    const int b = u >> 2, head = u & 3;
    attn_unit(p, l, KSB + (size_t)(l * 16 + b) * SROWS * 512 + head * 128, VTS + (size_t)((l * 16 + b) * 4 + head) * 128 * SROWS,
              SROWS, TP + b * 16, 1024, 17, head, true, smem, lam, M2, oscale);
  }
  unsigned* ctr = (unsigned*)(p.ws + WS_PAR) + 16 + l;
  while (true) {
    __syncthreads();
    if (tidx(p) == 0) *s_item = (int)atomicAdd(ctr, 1u);
    __syncthreads();
    const int item = *s_item;
    if (item >= 576) break;
    if (item < 64) sgu_sample_unit(p, l, item >> 2, item & 3);
    else { const int j = item - 64; sgu_unit(p, l, j >> 6, (j >> 2) & 15, j & 3, smem); }
  }
}

DI void phase_out(const Params& p, int l, char* smem) {
  const ushort_t* Y = (const ushort_t*)(p.ws + WS_Y);
  const ushort_t* Wt = (const ushort_t*)(p.ws + WS_WOUT) + (size_t)l * DM * DM;
  ushort_t* XB = (ushort_t*)(p.ws + WS_XB);
  float* ssq1 = (float*)(p.ws + WS_SSQ) + TT;
  const int G = gridDim.x;
  constexpr int NTILES = 64 * 4;
  for (int id = blockIdx.x; id < NTILES; id += G) {
    const int mt = id >> 2, ntile = id & 3;
    f32x4 acc[2][2][4][2];
    gemm256(Wt + (size_t)ntile * 256 * 1024, Y + (size_t)mt * 256 * 1024, acc, smem, tidx(p));
    int t_ = tidx(p); asm volatile("" : "+v"(t_));
    const int tid = t_, wid = tid >> 6, lane = tid & 63, wr = wid >> 2, wc = wid & 3, fr = lane & 15, fq = lane >> 4;
#pragma unroll
    for (int bj = 0; bj < 2; ++bj)
#pragma unroll
      for (int n = 0; n < 2; ++n) {
        const int tk = mt * 256 + bj * 128 + wc * 32 + n * 16 + fr;
        float* orow = p.out + (size_t)tk * 1024;
        float s = 0.f;
#pragma unroll
        for (int ai = 0; ai < 2; ++ai)
#pragma unroll
          for (int m = 0; m < 4; ++m) {
            const int c0 = ntile * 256 + ai * 128 + wr * 64 + m * 16 + fq * 4;
            const u32x2 xb = *(const u32x2*)(XB + (size_t)tk * 1024 + c0);
            f32x4 xv = {bflo(xb.x), bfhi(xb.x), bflo(xb.y), bfhi(xb.y)};
            xv += acc[ai][bj][m][n];
            if (l == 1) __builtin_nontemporal_store(xv, (f32x4*)(orow + c0));
            if (l == 0) {
              s += xv.x * xv.x + xv.y * xv.y + xv.z * xv.z + xv.w * xv.w;
              u32x2 o; o.x = pk(xv.x, xv.y); o.y = pk(xv.z, xv.w);
              *(u32x2*)(XB + (size_t)tk * 1024 + c0) = o;
            }
          }
        if (l == 0) {
          s += __shfl_xor(s, 16); s += __shfl_xor(s, 32);
          if (fq == 0) atomicAdd(ssq1 + tk, s);
        }
      }
  }
  for (int it = blockIdx.x; it < 256; it += G) {
    const int tid = tidx(p), wid = tid >> 6, lane = tid & 63, fr = lane & 15, fq = lane >> 4;
    const int sl = it >> 2, tg = it & 3, tt = wid & 3, kh = wid >> 2;
    const int tk = TP + tg * 64 + tt * 16 + fr;
    const ushort_t* wp = Wt + (size_t)(sl * 16 + fr) * 1024 + kh * 512 + fq * 8;
    const ushort_t* yp = Y + (size_t)tk * 1024 + kh * 512 + fq * 8;
    bf16x8 wf[16], yf[16];
#pragma unroll
    for (int q = 0; q < 16; ++q) { wf[q] = *(const bf16x8*)(wp + q * 32); yf[q] = *(const bf16x8*)(yp + q * 32); }
    f32x4 a0 = {0.f, 0.f, 0.f, 0.f};
#pragma unroll
    for (int q = 0; q < 16; ++q) a0 = MFMA16(wf[q], yf[q], a0);
    float* cx = (float*)smem;
    __syncthreads();
    if (kh == 1) *(f32x4*)(cx + (tt * 64 + lane) * 4) = a0;
    __syncthreads();
    if (kh == 0) {
      a0 += *(const f32x4*)(cx + (tt * 64 + lane) * 4);
      const int c0 = sl * 16 + fq * 4;
      const u32x2 xb = *(const u32x2*)(XB + (size_t)tk * 1024 + c0);
      f32x4 xv = {bflo(xb.x), bfhi(xb.x), bflo(xb.y), bfhi(xb.y)};
      xv += a0;
      if (l == 1) *(f32x4*)(p.out + (size_t)tk * 1024 + c0) = xv;
      if (l == 0) {
        float sq = xv.x * xv.x + xv.y * xv.y + xv.z * xv.z + xv.w * xv.w;
        u32x2 o; o.x = pk(xv.x, xv.y); o.y = pk(xv.z, xv.w);
        *(u32x2*)(XB + (size_t)tk * 1024 + c0) = o;
        sq += __shfl_xor(sq, 16); sq += __shfl_xor(sq, 32);
        if (fq == 0) atomicAdd(ssq1 + tk, sq);
      }
    }
  }
}

DI unsigned bar_ld(unsigned* p) { return __hip_atomic_load(p, __ATOMIC_RELAXED, __HIP_MEMORY_SCOPE_AGENT); }
DI unsigned bar_add(unsigned* p, unsigned v) { return __hip_atomic_fetch_add(p, v, __ATOMIC_RELAXED, __HIP_MEMORY_SCOPE_AGENT); }
DI unsigned xcc_id() { return (unsigned)__builtin_amdgcn_s_getreg((3 << 11) | 20) & 0xFu; }

DI void grid_barrier(unsigned* ctr, unsigned target, bool leader) {
  asm volatile("s_waitcnt vmcnt(0)" ::: "memory");
  __syncthreads();
  if (leader) {
    __builtin_amdgcn_fence(__ATOMIC_RELEASE, "agent");
    asm volatile("s_waitcnt vmcnt(0)" ::: "memory");
    bar_add(ctr, 1u);
    while (bar_ld(ctr) < target) __builtin_amdgcn_s_sleep(1);
    __builtin_amdgcn_fence(__ATOMIC_ACQUIRE, "agent");
    asm volatile("s_waitcnt vmcnt(0)" ::: "memory");
  }
  __syncthreads();
}
DI void xcd_barrier(unsigned* bar, unsigned round, const unsigned* s_nxcc, bool leader) {
  asm volatile("s_waitcnt vmcnt(0)" ::: "memory");
  __syncthreads();
  if (leader) {
    const unsigned xcc = xcc_id(), nxcc = *s_nxcc;
    const unsigned mine = bar_ld(bar + 64 + 64 * xcc);
    const unsigned old = bar_add(bar + 1088 + 64 * xcc, 1u);
    if (old + 1u == round * mine) {
      __builtin_amdgcn_fence(__ATOMIC_RELEASE, "agent");
      asm volatile("s_waitcnt vmcnt(0)" ::: "memory");
      bar_add(bar + 2112, 1u);
    }
    while (bar_ld(bar + 2112) < round * nxcc) __builtin_amdgcn_s_sleep(1);
    __builtin_amdgcn_fence(__ATOMIC_ACQUIRE, "agent");
    asm volatile("s_waitcnt vmcnt(0)" ::: "memory");
  }
  __syncthreads();
}

__global__ void __launch_bounds__(512, 1) mega_kernel(Params p0) {
  PW p;
  static_cast<Params&>(p) = p0;
  p.wv = __builtin_amdgcn_readfirstlane((int)(threadIdx.x >> 6));
  const bool leader = (tidx(p) == 0);
  __shared__ __attribute__((aligned(16))) char smem[SMEM_BYTES];
  __shared__ int s_item;
  __shared__ unsigned s_nxcc;
  cg::grid_group grid = cg::this_grid();
  if (p0.ws == nullptr) grid.sync();
  unsigned* bar = (unsigned*)(p.ws + WS_BAR);
  const unsigned G = gridDim.x;
  if (leader) bar_add(bar + 64 + 64 * xcc_id(), 1u);
  phase_prep(p, smem);
  if (leader) {
    unsigned n, tot;
    do {
      n = 0; tot = 0;
      for (int x = 0; x < 16; ++x) { const unsigned c = bar_ld(bar + 64 + 64 * x); tot += c; n += (c != 0u) ? 1u : 0u; }
      if (tot < G) __builtin_amdgcn_s_sleep(1);
    } while (tot < G);
    s_nxcc = n;
  }
  xcd_barrier(bar, 1, &s_nxcc, leader);
#pragma unroll 1
  for (int l = 0; l < 2; ++l) {
    phase_in(p, l, smem);
    xcd_barrier(bar, 3 * l + 2, &s_nxcc, leader);
    phase_mix(p, l, smem, &s_item);
    xcd_barrier(bar, 3 * l + 3, &s_nxcc, leader);
    phase_out(p, l, smem);
    if (l == 0) xcd_barrier(bar, 4, &s_nxcc, leader);
  }
}

extern "C" void kernel_launch(void* const* d_in, const int* in_sizes, int n_in, void* d_out, int out_size, void* d_ws,
                              size_t ws_size, hipStream_t stream) {
  static int grid_blocks = 0;
  if (!grid_blocks) {
    int dev = 0, cus = 0, per_cu = 0;
    (void)hipGetDevice(&dev);
    (void)hipDeviceGetAttribute(&cus, hipDeviceAttributeMultiprocessorCount, dev);
    (void)hipOccupancyMaxActiveBlocksPerMultiprocessor(&per_cu, mega_kernel, 512, 0);
    if (per_cu > 1) per_cu = 1;
    if (per_cu < 1) per_cu = 1;
    grid_blocks = cus * per_cu;
  }
  Params p{};
  p.x_prompt = (const float*)d_in[0]; p.x_sample = (const float*)d_in[1];
  p.cache_k = (const float*)d_in[2]; p.cache_v = (const float*)d_in[3];
  p.norm_g = (const float*)d_in[4]; p.w_in = (const float*)d_in[5];
  p.sgu_norm_g = (const float*)d_in[6]; p.sgu_w = (const float*)d_in[7]; p.sgu_b = (const float*)d_in[8];
  p.q_norm_g = (const float*)d_in[9]; p.k_norm_g = (const float*)d_in[10];
  p.lq1 = (const float*)d_in[11]; p.lk1 = (const float*)d_in[12]; p.lq2 = (const float*)d_in[13]; p.lk2 = (const float*)d_in[14];
  p.subln_g = (const float*)d_in[15]; p.w_out = (const float*)d_in[16];
  p.out = (float*)d_out; p.ws = (char*)d_ws;
  (void)hipMemsetAsync((char*)d_ws + WS_BAR, 0, 16384, stream);
  void* args[] = {&p};
  hipError_t e = hipLaunchCooperativeKernel((void*)mega_kernel, dim3(grid_blocks), dim3(512), args, 0, stream);
  if (e != hipSuccess) fprintf(stderr, "cooperative launch failed: %s (grid %d)\n", hipGetErrorString(e), grid_blocks);
}
```

```cpp
#include <hip/hip_runtime.h>
#include <hip/hip_cooperative_groups.h>
#include <cstdio>
namespace cg = cooperative_groups;

typedef __attribute__((ext_vector_type(8))) short bf16x8;
typedef __attribute__((ext_vector_type(16))) float f32x16;
typedef __attribute__((ext_vector_type(4))) float f32x4;
typedef __bf16 bf16x2_t __attribute__((ext_vector_type(2)));
typedef float f32x2_t __attribute__((ext_vector_type(2)));
typedef unsigned short ushort_t;
typedef unsigned u32x4 __attribute__((ext_vector_type(4)));
typedef unsigned u32x2 __attribute__((ext_vector_type(2)));

#define DI __device__ __forceinline__
#define MFMA32(a, b, c) __builtin_amdgcn_mfma_f32_32x32x16_bf16((a), (b), (c), 0, 0, 0)
#define MFMA16(a, b, c) __builtin_amdgcn_mfma_f32_16x16x32_bf16((a), (b), (c), 0, 0, 0)
#define GLDS(gp, lp) __builtin_amdgcn_global_load_lds((const unsigned*)(gp), (unsigned*)(lp), 16, 0, 0)
#define WAIT_V(n) asm volatile("s_waitcnt vmcnt(" #n ")" ::: "memory")
#define WAIT_L(n) asm volatile("s_waitcnt lgkmcnt(" #n ")" ::: "memory")
#define BAR __builtin_amdgcn_s_barrier()
#define SCHED __builtin_amdgcn_sched_barrier(0)
#define LDS_BARRIER() do { asm volatile("s_waitcnt lgkmcnt(0)" ::: "memory"); __builtin_amdgcn_s_barrier(); asm volatile("" ::: "memory"); } while (0)
#define DSR(dst, addr, imm) asm volatile("ds_read_b128 %0, %1 offset:%2" : "=v"(dst) : "v"(addr), "n"(imm))

constexpr int DM = 1024, NIN = 3584, TP = 16384, TT = 16640;
constexpr int SROWS = 1088;
constexpr float EPS = 1e-6f;
constexpr float LOG2E = 1.4426950408889634f;

constexpr size_t OKP = 17039360, OVP = 33816576, OKS = 50593792, OVS = 50855936, OSGU = 51118080;

constexpr size_t SZ_ACT = (size_t)TT * 512 * 2;
constexpr size_t WS_WIN = 0;
constexpr size_t WS_WOUT = WS_WIN + (size_t)2 * NIN * DM * 2;
constexpr size_t WS_XB = WS_WOUT + (size_t)2 * DM * DM * 2;
constexpr size_t WS_UG = WS_XB + (size_t)TT * 1024 * 2;
constexpr size_t WS_Q = WS_UG + SZ_ACT;
constexpr size_t WS_K = WS_Q + SZ_ACT;
constexpr size_t WS_GB = WS_K + SZ_ACT;
constexpr size_t WS_VNT = WS_GB + SZ_ACT;
constexpr size_t WS_VNS = WS_VNT + (size_t)32 * 128 * 2048 * 2;
constexpr size_t WS_VT = WS_VNS + (size_t)256 * 512 * 2;
constexpr size_t WS_Y = WS_VT + (size_t)32 * 128 * 2048 * 2;
constexpr size_t WS_KSB = WS_Y + (size_t)TT * 1024 * 2;
constexpr size_t WS_VTS = WS_KSB + (size_t)2 * 16 * SROWS * 512 * 2;
constexpr size_t WS_SSQ = WS_VTS + (size_t)2 * 16 * 4 * 128 * SROWS * 2;
constexpr size_t WS_PAR = WS_SSQ + (size_t)2 * TT * 4;
constexpr size_t WS_BAR = WS_PAR + 256;
constexpr size_t WS_END = WS_BAR + 16384;
static_assert(WS_END <= (size_t)256 * 1024 * 1024, "workspace too large");

constexpr int EX_OFF = 131072;
constexpr int RS_OFF = 131072 + 4096;
constexpr int SMEM_BYTES = 131072 + 4096 + 1024 + 64;

struct Params {
  const float* x_prompt; const float* x_sample; const float* cache_k; const float* cache_v;
  const float* norm_g; const float* w_in; const float* sgu_norm_g; const float* sgu_w; const float* sgu_b;
  const float* q_norm_g; const float* k_norm_g; const float* lq1; const float* lk1; const float* lq2; const float* lk2;
  const float* subln_g; const float* w_out;
  float* out; char* ws;
};
struct PW : Params { int wv; };
__device__ __forceinline__ int tidx(const Params& p) {
  int lane;
  asm volatile("v_mbcnt_lo_u32_b32 %0, -1, 0\n\tv_mbcnt_hi_u32_b32 %0, -1, %0" : "=v"(lane));
  return static_cast<const PW&>(p).wv * 64 + lane;
}

DI unsigned pk(float a, float b) {
  f32x2_t v = {a, b};
  bf16x2_t r = __builtin_convertvector(v, bf16x2_t);
  return __builtin_bit_cast(unsigned, r);
}
DI float bflo(unsigned u) { return __uint_as_float(u << 16); }
DI float bfhi(unsigned u) { return __uint_as_float(u & 0xffff0000u); }
DI float silu(float v) { return v * __builtin_amdgcn_rcpf(1.f + __expf(-v)); }
DI u32x4 pk8(f32x4 a, f32x4 b) {
  u32x4 r; r.x = pk(a.x, a.y); r.y = pk(a.z, a.w); r.z = pk(b.x, b.y); r.w = pk(b.z, b.w); return r;
}
DI int kperm(int k16) { return 8 * ((k16 >> 2) & 1) + (k16 & 3) + 4 * (k16 >> 3); }
DI int kinv(int p16) { return 8 * ((p16 & 7) >> 2) + 4 * (p16 >> 3) + (p16 & 3); }

struct TTRegs { f32x4 v[2]; float g[2]; };
DI void tt_load(TTRegs& R, const float* src, size_t sstride, const float* g, int t) {
#pragma unroll
  for (int i = 0; i < 2; ++i) {
    const int f = t + 512 * i, r = f >> 4, c4 = f & 15;
    R.v[i] = __builtin_nontemporal_load((const f32x4*)(src + (size_t)r * sstride + c4 * 4));
    R.g[i] = g ? g[r] : 1.f;
  }
}
DI void tt_to_lds(const TTRegs& R, float* tile, int t) {
#pragma unroll
  for (int i = 0; i < 2; ++i) {
    const int f = t + 512 * i, r = f >> 4, c4 = f & 15;
    float* tp = tile + r * 65 + c4 * 4;
    tp[0] = R.v[i].x * R.g[i]; tp[1] = R.v[i].y * R.g[i]; tp[2] = R.v[i].z * R.g[i]; tp[3] = R.v[i].w * R.g[i];
  }
}
DI void tt_store(ushort_t* dst, size_t dstride, bool perm, const float* tile, int t) {
  const int c = t >> 3, k8 = t & 7;
  float v[8];
#pragma unroll
  for (int e = 0; e < 8; ++e) {
    const int p = k8 * 8 + e;
    const int r = perm ? ((p & ~15) + kinv(p & 15)) : p;
    v[e] = tile[r * 65 + c];
  }
  u32x4 o; o.x = pk(v[0], v[1]); o.y = pk(v[2], v[3]); o.z = pk(v[4], v[5]); o.w = pk(v[6], v[7]);
  *(u32x4*)(dst + (size_t)c * dstride + k8 * 8) = o;
}

DI int src_section(int sec) {
  const int nt = sec >> 1, ai = sec & 1;
  if (nt < 4) return ai ? 8 + nt : nt;
  if (nt < 6) return 4 + 2 * (nt - 4) + ai;
  if (nt < 10) return ai ? 16 + (nt - 6) : 12 + (nt - 6);
  return ai ? 24 + (nt - 10) : 20 + (nt - 10);
}

DI void phase_prep(const Params& p, char* smem) {
  float* tile = (float*)smem;
  int t_ = tidx(p); asm volatile("" : "+v"(t_));
  const int t = t_, lane = t & 63, w = t >> 6;
  const int G = gridDim.x;
  {
    struct TJob { const float* src; size_t ss; ushort_t* dst; size_t ds; const float* g; bool perm; };
    auto job = [&](int item) {
      TJob J;
      if (item < 2304) {
        const int l = item / 1152;
        int idx = item % 1152;
        if (idx < 896) {
          const int kt = idx / 56, db = idx % 56;
          const int sb = src_section(db >> 1) * 2 + (db & 1);
          J.src = p.w_in + (size_t)l * DM * NIN + (size_t)(kt * 64) * NIN + sb * 64; J.ss = NIN;
          J.dst = (ushort_t*)(p.ws + WS_WIN) + (size_t)l * NIN * DM + (size_t)(db * 64) * DM + kt * 64; J.ds = DM;
          J.g = p.norm_g + l * DM + kt * 64; J.perm = false;
        } else {
          idx -= 896;
          const int kt = idx / 16, nb = idx % 16;
          J.src = p.w_out + (size_t)l * DM * DM + (size_t)(kt * 64) * DM + nb * 64; J.ss = DM;
          J.dst = (ushort_t*)(p.ws + WS_WOUT) + (size_t)l * DM * DM + (size_t)(nb * 64) * DM + kt * 64; J.ds = DM;
          J.g = nullptr; J.perm = false;
        }
      } else {
        const int it = item - 2304;
        const int dh = it & 1, head = (it >> 1) & 3, pt = (it >> 3) & 15, lb = it >> 7;
        J.src = p.cache_v + ((size_t)lb * 1024 + pt * 64) * 512 + head * 128 + dh * 64; J.ss = 512;
        J.dst = (ushort_t*)(p.ws + WS_VTS) + ((size_t)(lb * 4 + head) * 128 + dh * 64) * SROWS + pt * 64; J.ds = SROWS;
        J.g = nullptr; J.perm = true;
      }
      return J;
    };
    constexpr int NJ = 2304 + 4096;
    TTRegs R[4];
    TJob J[4];
    int item = blockIdx.x * 4;
    if (item < NJ) {
#pragma unroll
      for (int u = 0; u < 4; ++u) { J[u] = job(item + u); tt_load(R[u], J[u].src, J[u].ss, J[u].g, t); }
    }
    while (item < NJ) {
      __syncthreads();
#pragma unroll
      for (int u = 0; u < 4; ++u) tt_to_lds(R[u], tile + u * 4160, t);
      __syncthreads();
      TJob Jc[4];
#pragma unroll
      for (int u = 0; u < 4; ++u) Jc[u] = J[u];
      const int nxt = item + G * 4;
      if (nxt < NJ) {
#pragma unroll
        for (int u = 0; u < 4; ++u) { J[u] = job(nxt + u); tt_load(R[u], J[u].src, J[u].ss, J[u].g, t); }
      }
#pragma unroll
      for (int u = 0; u < 4; ++u) tt_store(Jc[u].dst, Jc[u].ds, Jc[u].perm, tile + u * 4160, t);
      item = nxt;
    }
  }
  {
    ushort_t* XB = (ushort_t*)(p.ws + WS_XB);
    float* ssq = (float*)(p.ws + WS_SSQ);
    for (int row0 = (blockIdx.x * 8 + w) * 4; row0 < TT; row0 += G * 32) {
      f32x4 v[4][4];
#pragma unroll
      for (int rr = 0; rr < 4; ++rr) {
        const int row = row0 + rr;
        const float* xr = (row < TP) ? p.x_prompt + (size_t)row * 1024 : p.x_sample + (size_t)(row - TP) * 1024;
#pragma unroll
        for (int i = 0; i < 4; ++i) v[rr][i] = __builtin_nontemporal_load((const f32x4*)(xr + i * 256 + lane * 4));
      }
#pragma unroll
      for (int rr = 0; rr < 4; ++rr) {
        const int row = row0 + rr;
        float sq = 0.f;
#pragma unroll
        for (int i = 0; i < 4; ++i) {
          const f32x4 a = v[rr][i];
          sq += a.x * a.x + a.y * a.y + a.z * a.z + a.w * a.w;
          u32x2 o; o.x = pk(a.x, a.y); o.y = pk(a.z, a.w);
          *(u32x2*)(XB + (size_t)row * 1024 + i * 256 + lane * 4) = o;
        }
#pragma unroll
        for (int m = 1; m < 64; m <<= 1) sq += __shfl_xor(sq, m);
        if (lane == 0) { ssq[row] = sq; ssq[TT + row] = 0.f; }
      }
    }
  }
  {
    ushort_t* KSB = (ushort_t*)(p.ws + WS_KSB);
    for (int row0 = (blockIdx.x * 8 + w) * 4; row0 < 32768; row0 += G * 32) {
      f32x4 a[4], b4[4];
#pragma unroll
      for (int rr = 0; rr < 4; ++rr) {
        const float* sr = p.cache_k + (size_t)(row0 + rr) * 512 + lane * 8;
        a[rr] = __builtin_nontemporal_load((const f32x4*)sr); b4[rr] = __builtin_nontemporal_load((const f32x4*)(sr + 4));
      }
#pragma unroll
      for (int rr = 0; rr < 4; ++rr) {
        const int row = row0 + rr, lb = row >> 10, pos = row & 1023;
        *(u32x4*)(KSB + ((size_t)lb * SROWS + pos) * 512 + lane * 8) = pk8(a[rr], b4[rr]);
      }
    }
  }
  if (blockIdx.x == 0 && w == 0) {
#pragma unroll
    for (int l = 0; l < 2; ++l) {
      float s1 = p.lq1[l * 64 + lane] * p.lk1[l * 64 + lane];
      float s2 = p.lq2[l * 64 + lane] * p.lk2[l * 64 + lane];
      float mq = fabsf(p.q_norm_g[l * 64 + lane]);
      float mk = fabsf(p.k_norm_g[l * 64 + lane]);
#pragma unroll
      for (int m = 1; m < 64; m <<= 1) {
        s1 += __shfl_xor(s1, m); s2 += __shfl_xor(s2, m);
        mq = fmaxf(mq, __shfl_xor(mq, m)); mk = fmaxf(mk, __shfl_xor(mk, m));
      }
      if (lane == 0) {
        const float lam_init = 0.8f - 0.6f * expf(-0.3f * (float)l);
        float* par = (float*)(p.ws + WS_PAR);
        par[l * 4 + 0] = expf(s1) - expf(s2) + lam_init;
        par[l * 4 + 1] = 8.f * mq * mk * 1.03f * LOG2E + 0.25f;
        par[l * 4 + 2] = 1.f - lam_init;
        atomicExch((unsigned*)(p.ws + WS_PAR) + 16 + l, 0u);
      }
    }
  }
}

DI int lds_byte(int r, int c) {
  const int st = (r >> 4) * 2 + (c >> 5), rr = r & 15, cc = c & 31, ob = rr * 64 + cc * 2;
  return st * 1024 + (ob ^ (((ob >> 9) & 1) << 5));
}
DI void stage_rc(int b, int& R, int& C) {
  const int st = b / 1024, sb = b % 1024, swz = sb ^ (((sb >> 9) & 1) << 5);
  R = (st >> 1) * 16 + swz / 64; C = (st & 1) * 32 + (swz % 64) / 2;
}

DI void gemm256(const ushort_t* A, const ushort_t* Bt, f32x4 (&acc)[2][2][4][2], char* shmc, int tid_in) {
  constexpr int K = 1024, BK = 64, HALF = 128, HT = HALF * BK;
  ushort_t* shm = (ushort_t*)shmc;
#define SA(b, h) (shm + ((b) * 2 + (h)) * HT)
#define SB(b, h) (shm + (4 + (b) * 2 + (h)) * HT)
#define STAGE(P, BASE, br, kt) do { const long _g = (long)(br) * K + (long)(kt) * BK; \
    _Pragma("unroll") for (int _i = 0; _i < 2; ++_i) { const int _b = tid * 16 + _i * 8192; int _r, _c; stage_rc(_b, _r, _c); \
      GLDS(BASE + _g + (long)_r * K + _c, (char*)(P) + _b); } } while (0)
#define LDA(dst, b, h) do { const unsigned _a = a_base + ((b) * 2 + (h)) * 16384u; \
    DSR(dst[0][0], _a, 0); DSR(dst[0][1], _a, 1024); DSR(dst[1][0], _a, 2048); DSR(dst[1][1], _a, 3072); \
    DSR(dst[2][0], _a, 4096); DSR(dst[2][1], _a, 5120); DSR(dst[3][0], _a, 6144); DSR(dst[3][1], _a, 7168); } while (0)
#define LDB(dst, b, h) do { const unsigned _a = b_base + (4 + (b) * 2 + (h)) * 16384u; \
    DSR(dst[0][0], _a, 0); DSR(dst[0][1], _a, 1024); DSR(dst[1][0], _a, 2048); DSR(dst[1][1], _a, 3072); } while (0)
#define TIE(Bx) asm volatile("s_waitcnt lgkmcnt(0)" : "+v"(At[0][0]), "+v"(At[0][1]), "+v"(At[1][0]), "+v"(At[1][1]), \
    "+v"(At[2][0]), "+v"(At[2][1]), "+v"(At[3][0]), "+v"(At[3][1]), "+v"(Bx[0][0]), "+v"(Bx[0][1]), "+v"(Bx[1][0]), "+v"(Bx[1][1]))
#define MMA(ai, bj, At_, Bt_) do { __builtin_amdgcn_s_setprio(1); \
    _Pragma("unroll") for (int m = 0; m < 4; ++m) _Pragma("unroll") for (int n = 0; n < 2; ++n) _Pragma("unroll") for (int k = 0; k < 2; ++k) \
      acc[ai][bj][m][n] = MFMA16(At_[m][k], Bt_[n][k], acc[ai][bj][m][n]); \
    __builtin_amdgcn_s_setprio(0); } while (0)

  int tid_ = tid_in; asm volatile("" : "+v"(tid_));
  const int tid = tid_;
  const int wid = tid >> 6, lane = tid & 63, wr = wid >> 2, wc = wid & 3, fr = lane & 15, fq = lane >> 4;
  const unsigned lds0 = (unsigned)(size_t)shmc;
  const unsigned a_base = lds0 + wr * 8192 + lds_byte(fr, fq * 8);
  const unsigned b_base = lds0 + wc * 4096 + lds_byte(fr, fq * 8);
#pragma unroll
  for (int a = 0; a < 2; ++a)
#pragma unroll
    for (int b = 0; b < 2; ++b)
#pragma unroll
      for (int m = 0; m < 4; ++m)
#pragma unroll
        for (int n = 0; n < 2; ++n) acc[a][b][m][n] = (f32x4){0.f, 0.f, 0.f, 0.f};
  bf16x8 At[4][2], B0[2][2], B1[2][2];
  constexpr int nt = K / BK;
  STAGE(SB(0, 0), Bt, 0, 0); STAGE(SA(0, 0), A, 0, 0);
  STAGE(SB(0, 1), Bt, HALF, 0); STAGE(SA(0, 1), A, HALF, 0);
  if (wr == 1) BAR;
  WAIT_V(4); BAR;
  STAGE(SB(1, 0), Bt, 0, 1); STAGE(SA(1, 0), A, 0, 1); STAGE(SB(1, 1), Bt, HALF, 1);
  WAIT_V(6); BAR;
#pragma unroll 1
  for (int t = 0; t < nt - 2; t += 2) {
    LDB(B0, 0, 0); SCHED; LDA(At, 0, 0); STAGE(SA(1, 1), A, HALF, t + 1);
    WAIT_L(8); BAR; TIE(B0); MMA(0, 0, At, B0); BAR; SCHED;
    LDB(B1, 0, 1); STAGE(SB(0, 0), Bt, 0, t + 2);
    BAR; TIE(B1); MMA(0, 1, At, B1); BAR;
    LDA(At, 0, 1); STAGE(SA(0, 0), A, 0, t + 2);
    BAR; TIE(B0); MMA(1, 0, At, B0); BAR; SCHED;
    STAGE(SB(0, 1), Bt, HALF, t + 2);
    WAIT_V(6); BAR; MMA(1, 1, At, B1); BAR;
    LDB(B0, 1, 0); SCHED; LDA(At, 1, 0); STAGE(SA(0, 1), A, HALF, t + 2);
    WAIT_L(8); BAR; TIE(B0); MMA(0, 0, At, B0); BAR; SCHED;
    LDB(B1, 1, 1); STAGE(SB(1, 0), Bt, 0, t + 3);
    BAR; TIE(B1); MMA(0, 1, At, B1); BAR;
    LDA(At, 1, 1); STAGE(SA(1, 0), A, 0, t + 3);
    BAR; TIE(B0); MMA(1, 0, At, B0); BAR; SCHED;
    STAGE(SB(1, 1), Bt, HALF, t + 3);
    WAIT_V(6); BAR; MMA(1, 1, At, B1); BAR;
  }
  { LDB(B0, 0, 0); LDA(At, 0, 0); STAGE(SA(1, 1), A, HALF, nt - 1);
    BAR; TIE(B0); MMA(0, 0, At, B0); BAR;
    LDB(B1, 0, 1); BAR; TIE(B1); MMA(0, 1, At, B1); BAR;
    LDA(At, 0, 1); WAIT_V(4); BAR; TIE(B0); MMA(1, 0, At, B0); MMA(1, 1, At, B1); BAR; }
  { LDB(B0, 1, 0); LDA(At, 1, 0); WAIT_V(2); BAR; TIE(B0); MMA(0, 0, At, B0); BAR;
    LDB(B1, 1, 1); WAIT_V(0); BAR; TIE(B1); MMA(0, 1, At, B1); BAR;
    LDA(At, 1, 1); BAR; TIE(B0); MMA(1, 0, At, B0); MMA(1, 1, At, B1); BAR; }
  if (wr == 0) BAR;
#undef SA
#undef SB
#undef STAGE
#undef LDA
#undef LDB
#undef TIE
#undef MMA
}

DI void phase_in(const Params& p, int l, char* smem) {
  ushort_t* UG = (ushort_t*)(p.ws + WS_UG);
  ushort_t* Qb = (ushort_t*)(p.ws + WS_Q);
  ushort_t* Kb = (ushort_t*)(p.ws + WS_K);
  ushort_t* GB = (ushort_t*)(p.ws + WS_GB);
  ushort_t* VNT = (ushort_t*)(p.ws + WS_VNT);
  ushort_t* VNS = (ushort_t*)(p.ws + WS_VNS);
  ushort_t* VT = (ushort_t*)(p.ws + WS_VT);
  ushort_t* KSB = (ushort_t*)(p.ws + WS_KSB);
  ushort_t* VTS = (ushort_t*)(p.ws + WS_VTS);
  const ushort_t* XB = (const ushort_t*)(p.ws + WS_XB);
  const float* ssq = (const float*)(p.ws + WS_SSQ) + (size_t)l * TT;
  const ushort_t* Wt = (const ushort_t*)(p.ws + WS_WIN) + (size_t)l * NIN * DM;
  float* ex = (float*)(smem + EX_OFF);
  const int G = gridDim.x;
  constexpr int NTILES = 65 * 14;

  for (int id = blockIdx.x; id < NTILES; id += G) {
    int mt, ntile;
    if (id >= 242 && id < 256) { mt = 64; ntile = id - 242; }
    else {
      const int id2 = (id < 242) ? id : id - 14, grp = id2 / (8 * 14), rem = id2 % (8 * 14);
      mt = grp * 8 + (rem & 7); ntile = rem >> 3;
    }
    const float ssq_mine = ssq[mt * 256 + (tidx(p) & 255)];
    f32x4 acc[2][2][4][2];
    gemm256(Wt + (size_t)ntile * 256 * 1024, XB + (size_t)mt * 256 * 1024, acc, smem, tidx(p));

    int t_ = tidx(p); asm volatile("" : "+v"(t_));
    const int tid = t_, wid = tid >> 6, lane = tid & 63, wr = wid >> 2, wc = wid & 3, fr = lane & 15, fq = lane >> 4;
    const bool samp = (mt == 64);
    float* rsl = (float*)(smem + RS_OFF);
    if (tid < 256) rsl[tid] = rsqrtf(ssq_mine * (1.f / 1024.f) + EPS);
    LDS_BARRIER();
    float rs[2][2]; int tok[2][2];
#pragma unroll
    for (int bj = 0; bj < 2; ++bj)
#pragma unroll
      for (int n = 0; n < 2; ++n) {
        const int tl_ = bj * 128 + wc * 32 + n * 16 + fr;
        tok[bj][n] = mt * 256 + tl_;
        rs[bj][n] = rsl[tl_];
      }
    const int sc00 = wr * 64 + fq * 4;

    if (!samp) {
      const int pb = (mt * 256) >> 11, tt0 = (mt * 256) & 2047;
      int tokl[2][2];
#pragma unroll
      for (int bj = 0; bj < 2; ++bj)
#pragma unroll
        for (int n = 0; n < 2; ++n) tokl[bj][n] = bj * 128 + wc * 32 + n * 16 + fr;
      const bool oddl = (fr & 1) != 0;
      auto store_rows = [&](ushort_t* gdst) {
        LDS_BARRIER();
#pragma unroll
        for (int i = 0; i < 8; ++i) {
          const int idx = tid + 512 * i, row = idx >> 4, c = idx & 15;
          const u32x4 v = *(const u32x4*)(smem + row * 272 + c * 16);
          *(u32x4*)(gdst + (size_t)row * 512 + c * 8) = v;
        }
        LDS_BARRIER();
      };
      auto store_tr = [&](ushort_t* gdst) {
        LDS_BARRIER();
#pragma unroll
        for (int i = 0; i < 8; ++i) {
          const int idx = tid + 512 * i, d = idx >> 5, c = idx & 31;
          const u32x4 v = *(const u32x4*)(smem + d * 528 + c * 16);
          *(u32x4*)(gdst + (size_t)d * 2048 + c * 8) = v;
        }
        LDS_BARRIER();
      };
      auto tr_write = [&](int pos, int sc0, unsigned o0, unsigned o1) {
        const unsigned snd = oddl ? o0 : o1;
        const unsigned rcv = (unsigned)__builtin_amdgcn_mov_dpp((int)snd, 0xB1, 0xF, 0xF, true);
        unsigned w0, w1; int d;
        if (!oddl) { w0 = (o0 & 0xffffu) | (rcv << 16); w1 = (o0 >> 16) | (rcv & 0xffff0000u); d = sc0; }
        else { w0 = (rcv & 0xffffu) | (o1 << 16); w1 = (rcv >> 16) | (o1 & 0xffff0000u); d = sc0 + 2; }
        char* ip = smem + d * 528 + (pos >> 1) * 4;
        *(unsigned*)ip = w0; *(unsigned*)(ip + 528) = w1;
      };
      if (ntile < 4) {
        const int cb = ntile * 128;
#pragma unroll
        for (int bj = 0; bj < 2; ++bj)
#pragma unroll
          for (int n = 0; n < 2; ++n) {
            const float r = rs[bj][n];
#pragma unroll
            for (int m = 0; m < 4; ++m) {
              const f32x4 u = acc[0][bj][m][n] * r, g = acc[1][bj][m][n] * r;
              u32x2 o; o.x = pk(u.x * silu(g.x), u.y * silu(g.y)); o.y = pk(u.z * silu(g.z), u.w * silu(g.w));
              *(u32x2*)(smem + tokl[bj][n] * 272 + (sc00 + m * 16) * 2) = o;
            }
          }
        store_rows(UG + (size_t)(mt * 256) * 512 + cb);
      } else if (ntile < 6) {
        float part[2][2][2];
#pragma unroll
        for (int ai = 0; ai < 2; ++ai)
#pragma unroll
          for (int bj = 0; bj < 2; ++bj)
#pragma unroll
            for (int n = 0; n < 2; ++n) {
              float sq = 0.f;
#pragma unroll
              for (int m = 0; m < 4; ++m) {
                const f32x4 v = acc[ai][bj][m][n];
                sq += v.x * v.x + v.y * v.y + v.z * v.z + v.w * v.w;
              }
              sq += __shfl_xor(sq, 16); sq += __shfl_xor(sq, 32);
              part[ai][bj][n] = sq;
              if (fq == 0) ex[((wid * 2 + ai) * 4 + bj * 2 + n) * 16 + fr] = sq;
            }
        __syncthreads();
#pragma unroll
        for (int ai = 0; ai < 2; ++ai) {
          const int head = 2 * (ntile - 4) + ai;
          const float* gp = p.sgu_norm_g + l * 512 + head * 128;
#pragma unroll
          for (int bj = 0; bj < 2; ++bj)
#pragma unroll
            for (int n = 0; n < 2; ++n) {
              const float r = rs[bj][n];
              const float tot = (part[ai][bj][n] + ex[(((wid ^ 4) * 2 + ai) * 4 + bj * 2 + n) * 16 + fr]) * r * r;
              const float rn = rsqrtf(tot * (1.f / 128.f) + EPS) * r;
#pragma unroll
              for (int m = 0; m < 4; ++m) {
                const int sc0 = sc00 + m * 16;
                const f32x4 v = acc[ai][bj][m][n];
                const f32x4 gg = *(const f32x4*)(gp + sc0);
                tr_write(tokl[bj][n], sc0, pk(v.x * rn * gg.x, v.y * rn * gg.y), pk(v.z * rn * gg.z, v.w * rn * gg.w));
              }
            }
          store_tr(VNT + ((size_t)(pb * 4 + head) * 128) * 2048 + tt0);
        }
      } else if (ntile < 10) {
        const int head = ntile - 6, cb = head * 128;
#pragma unroll
        for (int ai = 0; ai < 2; ++ai) {
          const float* gp = (ai == 0 ? p.q_norm_g : p.k_norm_g) + l * 64;
#pragma unroll
          for (int bj = 0; bj < 2; ++bj)
#pragma unroll
            for (int n = 0; n < 2; ++n) {
              float sq = 0.f;
#pragma unroll
              for (int m = 0; m < 4; ++m) {
                const f32x4 v = acc[ai][bj][m][n];
                sq += v.x * v.x + v.y * v.y + v.z * v.z + v.w * v.w;
              }
              sq += __shfl_xor(sq, 16); sq += __shfl_xor(sq, 32);
              const float r = rs[bj][n];
              const float rn = rsqrtf(sq * r * r * (1.f / 64.f) + EPS) * r * (ai == 0 ? 0.125f * LOG2E : 1.f);
              const int tk = tok[bj][n];
#pragma unroll
              for (int m = 0; m < 4; ++m) {
                const int sc0 = sc00 + m * 16;
                const f32x4 gg = *(const f32x4*)(gp + fq * 4 + m * 16);
                const f32x4 v = acc[ai][bj][m][n] * rn * gg;
                u32x2 o; o.x = pk(v.x, v.y); o.y = pk(v.z, v.w);
                if (ai == 1) __builtin_nontemporal_store(v, (f32x4*)(p.out + OKP + (size_t)l * 8388608 + (size_t)tk * 512 + cb + sc0));
                *(u32x2*)(smem + tokl[bj][n] * 272 + sc0 * 2) = o;
              }
            }
          store_rows((ai == 0 ? Qb : Kb) + (size_t)(mt * 256) * 512 + cb);
        }
      } else {
        const int head = ntile - 10, cb = head * 128;
#pragma unroll
        for (int bj = 0; bj < 2; ++bj)
#pragma unroll
          for (int n = 0; n < 2; ++n) {
            const float r = rs[bj][n];
            const int tk = tok[bj][n];
            const int tl = tokl[bj][n];
            const int pos = (tl & ~15) + kperm(tl & 15);
#pragma unroll
            for (int m = 0; m < 4; ++m) {
              const int sc0 = sc00 + m * 16;
              const f32x4 v = acc[0][bj][m][n] * r;
              __builtin_nontemporal_store(v, (f32x4*)(p.out + OVP + (size_t)l * 8388608 + (size_t)tk * 512 + cb + sc0));
              tr_write(pos, sc0, pk(v.x, v.y), pk(v.z, v.w));
            }
          }
        store_tr(VT + ((size_t)(pb * 4 + head) * 128) * 2048 + tt0);
#pragma unroll
        for (int bj = 0; bj < 2; ++bj)
#pragma unroll
          for (int n = 0; n < 2; ++n) {
            const float r = rs[bj][n];
#pragma unroll
            for (int m = 0; m < 4; ++m) {
              const f32x4 g = acc[1][bj][m][n] * r;
              u32x2 o; o.x = pk(silu(g.x), silu(g.y)); o.y = pk(silu(g.z), silu(g.w));
              *(u32x2*)(smem + tokl[bj][n] * 272 + (sc00 + m * 16) * 2) = o;
            }
          }
        store_rows(GB + (size_t)(mt * 256) * 512 + cb);
      }
      continue;
    }
    if (ntile < 4) {
      const int cb = ntile * 128;
#pragma unroll
      for (int bj = 0; bj < 2; ++bj)
#pragma unroll
        for (int n = 0; n < 2; ++n) {
          const float r = rs[bj][n];
#pragma unroll
          for (int m = 0; m < 4; ++m) {
            const f32x4 u = acc[0][bj][m][n] * r, g = acc[1][bj][m][n] * r;
            u32x2 o; o.x = pk(u.x * silu(g.x), u.y * silu(g.y)); o.y = pk(u.z * silu(g.z), u.w * silu(g.w));
            *(u32x2*)(UG + (size_t)tok[bj][n] * 512 + cb + sc00 + m * 16) = o;
          }
        }
    } else if (ntile < 6) {
      float part[2][2][2];
#pragma unroll
      for (int ai = 0; ai < 2; ++ai)
#pragma unroll
        for (int bj = 0; bj < 2; ++bj)
#pragma unroll
          for (int n = 0; n < 2; ++n) {
            float s = 0.f;
#pragma unroll
            for (int m = 0; m < 4; ++m) {
              const f32x4 v = acc[ai][bj][m][n];
              s += v.x * v.x + v.y * v.y + v.z * v.z + v.w * v.w;
            }
            s += __shfl_xor(s, 16); s += __shfl_xor(s, 32);
            part[ai][bj][n] = s;
            if (fq == 0) ex[((wid * 2 + ai) * 4 + bj * 2 + n) * 16 + fr] = s;
          }
      __syncthreads();
#pragma unroll
      for (int ai = 0; ai < 2; ++ai) {
        const int head = 2 * (ntile - 4) + ai;
        const int cb = head * 128;
        const float* gp = p.sgu_norm_g + l * 512 + cb;
#pragma unroll
        for (int bj = 0; bj < 2; ++bj)
#pragma unroll
          for (int n = 0; n < 2; ++n) {
            const float r = rs[bj][n];
            const float tot = (part[ai][bj][n] + ex[(((wid ^ 4) * 2 + ai) * 4 + bj * 2 + n) * 16 + fr]) * r * r;
            const float rn = rsqrtf(tot * (1.f / 128.f) + EPS) * r;
            const int tk = tok[bj][n];
#pragma unroll
            for (int m = 0; m < 4; ++m) {
              const int sc0 = sc00 + m * 16;
              const f32x4 v = acc[ai][bj][m][n];
              const f32x4 gg = *(const f32x4*)(gp + sc0);
              const unsigned o0 = pk(v.x * rn * gg.x, v.y * rn * gg.y), o1 = pk(v.z * rn * gg.z, v.w * rn * gg.w);
              if (samp) {
                const int rs_ = tk - TP;
                *(f32x4*)(p.out + OSGU + (size_t)l * 131072 + (size_t)rs_ * 512 + cb + sc0) = v * r;
                u32x2 o; o.x = o0; o.y = o1;
                *(u32x2*)(VNS + (size_t)rs_ * 512 + cb + sc0) = o;
              } else {
                const int b = tk >> 11, tt = tk & 2047;
                ushort_t* vb = VNT + ((size_t)(b * 4 + head) * 128 + sc0) * 2048 + tt;
                vb[0] = (ushort_t)(o0 & 0xffff); vb[2048] = (ushort_t)(o0 >> 16);
                vb[4096] = (ushort_t)(o1 & 0xffff); vb[6144] = (ushort_t)(o1 >> 16);
              }
            }
          }
      }
      __syncthreads();
    } else if (ntile < 10) {
      const int head = ntile - 6, cb = head * 128;
#pragma unroll
      for (int ai = 0; ai < 2; ++ai) {
        const float* gp = (ai == 0 ? p.q_norm_g : p.k_norm_g) + l * 64;
#pragma unroll
        for (int bj = 0; bj < 2; ++bj)
#pragma unroll
          for (int n = 0; n < 2; ++n) {
            float s = 0.f;
#pragma unroll
            for (int m = 0; m < 4; ++m) {
              const f32x4 v = acc[ai][bj][m][n];
              s += v.x * v.x + v.y * v.y + v.z * v.z + v.w * v.w;
            }
            s += __shfl_xor(s, 16); s += __shfl_xor(s, 32);
            const float r = rs[bj][n];
            const float rn = rsqrtf(s * r * r * (1.f / 64.f) + EPS) * r * (ai == 0 ? 0.125f * LOG2E : 1.f);
            const int tk = tok[bj][n];
#pragma unroll
            for (int m = 0; m < 4; ++m) {
              const int sc0 = sc00 + m * 16;
              const f32x4 gg = *(const f32x4*)(gp + fq * 4 + m * 16);
              const f32x4 v = acc[ai][bj][m][n] * rn * gg;
              u32x2 o; o.x = pk(v.x, v.y); o.y = pk(v.z, v.w);
              if (ai == 0) {
                *(u32x2*)(Qb + (size_t)tk * 512 + cb + sc0) = o;
              } else if (samp) {
                const int rs_ = tk - TP, b = rs_ >> 4, tq = rs_ & 15;
                *(f32x4*)(p.out + OKS + (size_t)l * 131072 + (size_t)rs_ * 512 + cb + sc0) = v;
                *(u32x2*)(KSB + ((size_t)(l * 16 + b) * SROWS + 1024 + tq) * 512 + cb + sc0) = o;
              } else {
                *(f32x4*)(p.out + OKP + (size_t)l * 8388608 + (size_t)tk * 512 + cb + sc0) = v;
                *(u32x2*)(Kb + (size_t)tk * 512 + cb + sc0) = o;
              }
            }
          }
      }
    } else {
      const int head = ntile - 10, cb = head * 128;
#pragma unroll
      for (int bj = 0; bj < 2; ++bj)
#pragma unroll
        for (int n = 0; n < 2; ++n) {
          const float r = rs[bj][n];
          const int tk = tok[bj][n];
#pragma unroll
          for (int m = 0; m < 4; ++m) {
            const int sc0 = sc00 + m * 16;
            const f32x4 v = acc[0][bj][m][n] * r;
            const unsigned o0 = pk(v.x, v.y), o1 = pk(v.z, v.w);
            if (samp) {
              const int rs_ = tk - TP, b = rs_ >> 4, tq = rs_ & 15;
              *(f32x4*)(p.out + OVS + (size_t)l * 131072 + (size_t)rs_ * 512 + cb + sc0) = v;
              ushort_t* vb = VTS + ((size_t)((l * 16 + b) * 4 + head) * 128 + sc0) * SROWS + 1024 + kperm(tq);
              vb[0] = (ushort_t)(o0 & 0xffff); vb[SROWS] = (ushort_t)(o0 >> 16);
              vb[2 * SROWS] = (ushort_t)(o1 & 0xffff); vb[3 * SROWS] = (ushort_t)(o1 >> 16);
            } else {
              *(f32x4*)(p.out + OVP + (size_t)l * 8388608 + (size_t)tk * 512 + cb + sc0) = v;
              const int b = tk >> 11, tt = tk & 2047;
              ushort_t* vb = VT + ((size_t)(b * 4 + head) * 128 + sc0) * 2048 + (tt & ~15) + kperm(tt & 15);
              vb[0] = (ushort_t)(o0 & 0xffff); vb[2048] = (ushort_t)(o0 >> 16);
              vb[4096] = (ushort_t)(o1 & 0xffff); vb[6144] = (ushort_t)(o1 >> 16);
            }
            const f32x4 g = acc[1][bj][m][n] * r;
            u32x2 o; o.x = pk(silu(g.x), silu(g.y)); o.y = pk(silu(g.z), silu(g.w));
            *(u32x2*)(GB + (size_t)tk * 512 + cb + sc0) = o;
          }
        }
    }
  }
}

DI void attn_unit(const Params& p, int l, const ushort_t* Kp, const ushort_t* Vp, int vstride, int qrow0, int qpos0,
                  int ntiles, int head, bool sample, char* smem, float lam, float M2, float oscale) {
  int t_ = tidx(p); asm volatile("" : "+v"(t_));
  const int t = t_, lane = t & 63, w = t >> 6, l31 = lane & 31, h = lane >> 5;
  const int rg = sample ? (w >> 1) : (w & 3), hc = sample ? (w & 1) : (w >> 2);
  const ushort_t* Qb = (const ushort_t*)(p.ws + WS_Q);
  const ushort_t* GB = (const ushort_t*)(p.ws + WS_GB);
  ushort_t* Y = (ushort_t*)(p.ws + WS_Y);

  int qrow, qpos, mytiles;
  if (sample) { qrow = qrow0 + (l31 & 15); qpos = qpos0 + (l31 & 15); mytiles = (rg == 0) ? ntiles : 0; }
  else { qrow = qrow0 + rg * 32 + l31; qpos = qpos0 + rg * 32 + l31; mytiles = ntiles - 1 + (rg >> 1); }
  const int diagtile = sample ? 16 : (qpos0 >> 6) + (rg >> 1);
  bf16x8 qf[4];
#pragma unroll
  for (int ks = 0; ks < 4; ++ks) qf[ks] = *(const bf16x8*)(Qb + (size_t)qrow * 512 + head * 128 + hc * 64 + ks * 16 + h * 8);
  const float slope2 = exp2f(-2.f * (float)(head + 1)) * LOG2E;

  f32x16 ot[4];
#pragma unroll
  for (int dt = 0; dt < 4; ++dt)
#pragma unroll
    for (int i = 0; i < 16; ++i) ot[dt][i] = 0.f;
  float lsum = 0.f;

  const unsigned lds0 = (unsigned)(size_t)smem;
  unsigned koff[4], voff[4];
#pragma unroll
  for (int x = 0; x < 4; ++x) {
    koff[x] = (unsigned)(l31 * 256 + (((hc * 8 + x * 2 + h) ^ (l31 & 15)) * 16));
    voff[x] = (unsigned)(l31 * 128 + (((x * 2 + h) ^ ((l31 >> 1) & 7)) * 16));
  }
  unsigned ksrc[2], vsrc[2];
#pragma unroll
  for (int i = 0; i < 2; ++i) {
    const int o = t * 16 + i * 8192;
    const int row = o >> 8, cp = (o >> 4) & 15;
    ksrc[i] = (unsigned)(row * 512 + ((cp ^ (row & 15)) * 8)) * 2u;
    const int d = o >> 7, cv = (o >> 4) & 7;
    vsrc[i] = (unsigned)(d * vstride + ((cv ^ ((d >> 1) & 7)) * 8)) * 2u;
  }
  auto issue = [&](int j) {
    char* slot = smem + (j & 3) * 32768;
#pragma unroll
    for (int i = 0; i < 2; ++i) GLDS((const char*)(Kp + (size_t)j * 64 * 512) + ksrc[i], slot + t * 16 + i * 8192);
#pragma unroll
    for (int i = 0; i < 2; ++i) GLDS((const char*)(Vp + (size_t)j * 64) + vsrc[i], slot + 16384 + t * 16 + i * 8192);
  };
#define VREAD(dst, sl, x) do { const unsigned _a = (sl) + voff[x]; \
    DSR(dst[0], _a, 16384); DSR(dst[1], _a, 20480); DSR(dst[2], _a, 24576); DSR(dst[3], _a, 28672); } while (0)
#define VWAIT(n, v) asm volatile("s_waitcnt lgkmcnt(" #n ")" : "+v"(v[0]), "+v"(v[1]), "+v"(v[2]), "+v"(v[3]))
#define PVMMA(v, s2) do { _Pragma("unroll") for (int dt = 0; dt < 4; ++dt) ot[dt] = MFMA32(v[dt], pf[s2], ot[dt]); } while (0)
#define EXP8(kt, o8) do { _Pragma("unroll") for (int i = (o8); i < (o8) + 8; ++i) { \
    const float pv = __builtin_amdgcn_exp2f(st[kt][i]); lsum += pv; st[kt][i] = pv; } } while (0)

  asm volatile("" : "+v"(qf[0]), "+v"(qf[1]), "+v"(qf[2]), "+v"(qf[3]));
  __syncthreads();
  issue(0);
  if (ntiles > 1) issue(1);
  bf16x8 pf[4];
#pragma unroll
  for (int x = 0; x < 4; ++x) pf[x] = (bf16x8){0, 0, 0, 0, 0, 0, 0, 0};
#pragma unroll 1
  for (int j = 0; j <= ntiles; ++j) {
    if (j + 1 < ntiles) { WAIT_V(4); } else { WAIT_V(0); }
    BAR;
    if (j + 2 < ntiles) issue(j + 2);
    const bool doqk = (j < mytiles), dopv = (j >= 1 && j <= mytiles);
    const unsigned slot = lds0 + (unsigned)(j & 3) * 32768u;
    const unsigned pslot = lds0 + (unsigned)((j + 3) & 3) * 32768u;
    f32x16 st[2];
    bf16x8 va[4], vb[4];
    if (dopv) { VREAD(va, pslot, 0); VREAD(vb, pslot, 1); }
    if (doqk) {
      const int dq = qpos - 64 * j - 4 * h;
      bf16x8 ka[4], kb[4];
      {
        const unsigned a0 = slot + koff[0], a1 = slot + koff[1], a2 = slot + koff[2], a3 = slot + koff[3];
        DSR(ka[0], a0, 0); DSR(ka[1], a0, 8192); DSR(ka[2], a1, 0); DSR(ka[3], a1, 8192);
        DSR(kb[0], a2, 0); DSR(kb[1], a2, 8192); DSR(kb[2], a3, 0); DSR(kb[3], a3, 8192);
      }
      if (j < diagtile) {
        const float base = -slope2 * (float)dq - M2;
        float be[4];
#pragma unroll
        for (int e = 0; e < 4; ++e) be[e] = fmaf(slope2, (float)e, base);
#pragma unroll
        for (int kt = 0; kt < 2; ++kt)
#pragma unroll
          for (int g = 0; g < 4; ++g) {
            const float cs = __int_as_float(__builtin_amdgcn_readfirstlane(__float_as_int(slope2 * (float)(32 * kt + 8 * g))));
#pragma unroll
            for (int e = 0; e < 4; ++e) {
              float r;
              asm("v_add_f32 %0, %1, %2" : "=v"(r) : "s"(cs), "v"(be[e]));
              st[kt][4 * g + e] = r;
            }
          }
      } else {
        const bool lastmask = sample && (j == ntiles - 1);
#pragma unroll
        for (int kt = 0; kt < 2; ++kt)
#pragma unroll
          for (int i = 0; i < 16; ++i) {
            const int off = 32 * kt + 8 * (i >> 2) + (i & 3);
            const int dd = dq - off;
            float bv = -slope2 * (float)(dd < 0 ? -dd : dd) - M2;
            if (lastmask && (kt == 1 || (i >> 2) >= 2)) bv = -1e30f;
            st[kt][i] = bv;
          }
      }
      asm volatile("s_waitcnt lgkmcnt(4)" : "+v"(ka[0]), "+v"(ka[1]), "+v"(ka[2]), "+v"(ka[3]));
      st[0] = MFMA32(ka[0], qf[0], st[0]); st[1] = MFMA32(ka[1], qf[0], st[1]);
      st[0] = MFMA32(ka[2], qf[1], st[0]); st[1] = MFMA32(ka[3], qf[1], st[1]);
      asm volatile("s_waitcnt lgkmcnt(0)" : "+v"(kb[0]), "+v"(kb[1]), "+v"(kb[2]), "+v"(kb[3]));
      st[0] = MFMA32(kb[0], qf[2], st[0]); st[1] = MFMA32(kb[1], qf[2], st[1]);
      st[0] = MFMA32(kb[2], qf[3], st[0]); st[1] = MFMA32(kb[3], qf[3], st[1]);
    }
    if (doqk && dopv) {
      VWAIT(0, va); PVMMA(va, 0); EXP8(0, 0);
      VREAD(va, pslot, 2);
      VWAIT(4, vb); PVMMA(vb, 1); EXP8(0, 8);
      VREAD(vb, pslot, 3);
      VWAIT(4, va); PVMMA(va, 2); EXP8(1, 0);
      VWAIT(0, vb); PVMMA(vb, 3); EXP8(1, 8);
    } else if (doqk) {
      EXP8(0, 0); EXP8(0, 8); EXP8(1, 0); EXP8(1, 8);
    } else if (dopv) {
      VWAIT(4, va); PVMMA(va, 0);
      VREAD(va, pslot, 2);
      VWAIT(4, vb); PVMMA(vb, 1);
      VREAD(vb, pslot, 3);
      VWAIT(4, va); PVMMA(va, 2);
      VWAIT(0, vb); PVMMA(vb, 3);
    }
    if (doqk) {
#pragma unroll
      for (int s2 = 0; s2 < 4; ++s2) {
        const int kt = s2 >> 1, o8 = 8 * (s2 & 1);
        union { u32x4 u; bf16x8 v; } cv;
        cv.u.x = pk(st[kt][o8 + 0], st[kt][o8 + 1]);
        cv.u.y = pk(st[kt][o8 + 2], st[kt][o8 + 3]);
        cv.u.z = pk(st[kt][o8 + 4], st[kt][o8 + 5]);
        cv.u.w = pk(st[kt][o8 + 6], st[kt][o8 + 7]);
        pf[s2] = cv.v;
      }
    }
  }
#undef VREAD
#undef VWAIT
#undef PVMMA
#undef EXP8

  lsum += __shfl_xor(lsum, 32);
  const float inv = 1.f / lsum;
  __syncthreads();
  float* Ol = (float*)smem;
  if (hc == 1) {
    const float sc = lam * inv;
#pragma unroll
    for (int dt = 0; dt < 4; ++dt)
#pragma unroll
      for (int g = 0; g < 4; ++g) {
        const int d0 = 32 * dt + 8 * g + 4 * h;
        f32x4 v = {ot[dt][4 * g] * sc, ot[dt][4 * g + 1] * sc, ot[dt][4 * g + 2] * sc, ot[dt][4 * g + 3] * sc};
        *(f32x4*)(Ol + (rg * 32 + l31) * 132 + d0) = v;
      }
  }
  __syncthreads();
  if (hc == 0) {
    float ssq = 0.f;
#pragma unroll
    for (int dt = 0; dt < 4; ++dt)
#pragma unroll
      for (int g = 0; g < 4; ++g) {
        const int d0 = 32 * dt + 8 * g + 4 * h;
        const f32x4 v2 = *(const f32x4*)(Ol + (rg * 32 + l31) * 132 + d0);
        ot[dt][4 * g + 0] = ot[dt][4 * g + 0] * inv - v2.x;
        ot[dt][4 * g + 1] = ot[dt][4 * g + 1] * inv - v2.y;
        ot[dt][4 * g + 2] = ot[dt][4 * g + 2] * inv - v2.z;
        ot[dt][4 * g + 3] = ot[dt][4 * g + 3] * inv - v2.w;
        ssq += ot[dt][4 * g] * ot[dt][4 * g] + ot[dt][4 * g + 1] * ot[dt][4 * g + 1] + ot[dt][4 * g + 2] * ot[dt][4 * g + 2] +
               ot[dt][4 * g + 3] * ot[dt][4 * g + 3];
      }
    ssq += __shfl_xor(ssq, 32);
    const float rn = rsqrtf(ssq * (1.f / 128.f) + EPS) * oscale;
    const bool valid = sample ? (rg == 0 && l31 < 16) : true;
    const float* sg = p.subln_g + l * 128;
    ushort_t* yrow = Y + (size_t)qrow * 1024 + 512 + head * 128;
    const ushort_t* gbrow = GB + (size_t)qrow * 512 + head * 128;
#pragma unroll
    for (int dt = 0; dt < 4; ++dt)
#pragma unroll
      for (int gp = 0; gp < 2; ++gp) {
        u32x2 og[2];
#pragma unroll
        for (int q = 0; q < 2; ++q) {
          const int g = 2 * gp + q;
          const int d0 = 32 * dt + 8 * g + 4 * h;
          const u32x2 gb = *(const u32x2*)(gbrow + d0);
          const f32x4 gg = *(const f32x4*)(sg + d0);
          og[q].x = pk(ot[dt][4 * g] * rn * gg.x * bflo(gb.x), ot[dt][4 * g + 1] * rn * gg.y * bfhi(gb.x));
          og[q].y = pk(ot[dt][4 * g + 2] * rn * gg.z * bflo(gb.y), ot[dt][4 * g + 3] * rn * gg.w * bfhi(gb.y));
        }
        const u32x2 snd = h ? og[0] : og[1];
        u32x2 rcv;
        rcv.x = (unsigned)__shfl_xor((int)snd.x, 32);
        rcv.y = (unsigned)__shfl_xor((int)snd.y, 32);
        u32x4 o16;
        if (h == 0) { o16.x = og[0].x; o16.y = og[0].y; o16.z = rcv.x; o16.w = rcv.y; }
        else { o16.x = rcv.x; o16.y = rcv.y; o16.z = og[1].x; o16.w = og[1].y; }
        if (valid) *(u32x4*)(yrow + 32 * dt + 16 * gp + 8 * h) = o16;
      }
  }
}

DI void sgu_unit(const Params& p, int l, int b, int n, int head, char* smem) {
  int t_ = tidx(p); asm volatile("" : "+v"(t_));
  const int t = t_, lane = t & 63, w = t >> 6, l31 = lane & 31, h = lane >> 5;
  const int dtile = w & 3, th = w >> 2;
  const ushort_t* UG = (const ushort_t*)(p.ws + WS_UG);
  const ushort_t* VNT = (const ushort_t*)(p.ws + WS_VNT);
  ushort_t* Y = (ushort_t*)(p.ws + WS_Y);
  char* Wl = smem;
  const float* W = p.sgu_w + (size_t)(l * 4 + head) * 128 * 128;
  __syncthreads();
#pragma unroll
  for (int i = 0; i < 4; ++i) {
    const int f = t + 512 * i, row = f >> 4, c8 = f & 15;
    f32x4 a = *(const f32x4*)(W + row * 128 + c8 * 8);
    f32x4 bq = *(const f32x4*)(W + row * 128 + c8 * 8 + 4);
    const int s0 = c8 * 8;
    if (s0 + 0 > row) a.x = 0.f; if (s0 + 1 > row) a.y = 0.f; if (s0 + 2 > row) a.z = 0.f; if (s0 + 3 > row) a.w = 0.f;
    if (s0 + 4 > row) bq.x = 0.f; if (s0 + 5 > row) bq.y = 0.f; if (s0 + 6 > row) bq.z = 0.f; if (s0 + 7 > row) bq.w = 0.f;
    *(u32x4*)(Wl + row * 272 + c8 * 16) = pk8(a, bq);
  }
  bf16x8 af[8];
#pragma unroll
  for (int ks = 0; ks < 8; ++ks)
    af[ks] = *(const bf16x8*)(VNT + ((size_t)(b * 4 + head) * 128 + 32 * dtile + l31) * 2048 + n * 128 + ks * 16 + h * 8);
  __syncthreads();
  f32x16 acc[2];
#pragma unroll
  for (int q = 0; q < 2; ++q) {
#pragma unroll
    for (int i = 0; i < 16; ++i) acc[q][i] = 0.f;
#pragma unroll
    for (int ks = 0; ks < 8; ++ks) {
      if (ks <= 4 * th + 2 * q + 1) {
        const bf16x8 bw = *(const bf16x8*)(Wl + (32 * (2 * th + q) + l31) * 272 + ks * 32 + h * 16);
        acc[q] = MFMA32(af[ks], bw, acc[q]);
      }
    }
  }
#pragma unroll
  for (int q = 0; q < 2; ++q) {
    const int tt = 32 * (2 * th + q) + l31;
    const size_t r = (size_t)b * 2048 + n * 128 + tt;
    const float bias = p.sgu_b[(l * 4 + head) * 128 + tt];
#pragma unroll
    for (int g = 0; g < 4; ++g) {
      const int d0 = 32 * dtile + 8 * g + 4 * h;
      const u32x2 u = *(const u32x2*)(UG + r * 512 + head * 128 + d0);
      u32x2 o;
      o.x = pk((acc[q][4 * g] + bias) * bflo(u.x), (acc[q][4 * g + 1] + bias) * bfhi(u.x));
      o.y = pk((acc[q][4 * g + 2] + bias) * bflo(u.y), (acc[q][4 * g + 3] + bias) * bfhi(u.y));
      *(u32x2*)(Y + r * 1024 + head * 128 + d0) = o;
    }
  }
}

DI void sgu_sample_unit(const Params& p, int l, int b, int head) {
  const int t = tidx(p);
  const ushort_t* UG = (const ushort_t*)(p.ws + WS_UG);
  const ushort_t* VNS = (const ushort_t*)(p.ws + WS_VNS);
  ushort_t* Y = (ushort_t*)(p.ws + WS_Y);
  const float* W = p.sgu_w + (size_t)(l * 4 + head) * 128 * 128;
  for (int idx = t; idx < 2048; idx += 512) {
    const int tt = idx >> 7, d = idx & 127, col = head * 128 + d;
    float wv[16], vv[16];
#pragma unroll
    for (int q = 0; q < 16; ++q) {
      wv[q] = W[tt * 128 + q];
      vv[q] = bflo((unsigned)VNS[(size_t)(b * 16 + q) * 512 + col]);
    }
    float a = p.sgu_b[(l * 4 + head) * 128 + tt];
#pragma unroll
    for (int q = 0; q < 16; ++q) a += (q <= tt) ? wv[q] * vv[q] : 0.f;
    const size_t r = (size_t)TP + b * 16 + tt;
    const float y = a * bflo((unsigned)UG[r * 512 + col]);
    Y[r * 1024 + col] = (ushort_t)(pk(y, y) & 0xffff);
  }
}

DI void phase_mix(const Params& p, int l, char* smem, int* s_item) {
  const float* par = (const float*)(p.ws + WS_PAR);
  const float lam = par[l * 4 + 0], M2 = par[l * 4 + 1], oscale = par[l * 4 + 2];
  const int G = gridDim.x;
  const ushort_t* Kb = (const ushort_t*)(p.ws + WS_K);
  const ushort_t* VT = (const ushort_t*)(p.ws + WS_VT);
  const ushort_t* KSB = (const ushort_t*)(p.ws + WS_KSB);
  const ushort_t* VTS = (const ushort_t*)(p.ws + WS_VTS);
  for (int u0 = blockIdx.x; u0 < 256; u0 += G) {
    const int u = ((G & 7) == 0 && G >= 256) ? ((u0 & 7) * 32 + (u0 >> 3)) : u0;
    const int bh = u >> 3, pi = u & 7, b = bh >> 2, head = bh & 3;
#pragma unroll 1
    for (int half = 0; half < 2; ++half) {
      const int qb = half ? pi : 15 - pi;
      attn_unit(p, l, Kb + (size_t)b * 2048 * 512 + head * 128, VT + (size_t)(b * 4 + head) * 128 * 2048, 2048,
                b * 2048 + qb * 128, qb * 128, 2 * qb + 2, head, false, smem, lam, M2, oscale);
    }
  }
  for (int u = blockIdx.x; u < 64; u += G) {
    const int b = u >> 2, head = u & 3;
    attn_unit(p, l, KSB + (size_t)(l * 16 + b) * SROWS * 512 + head * 128, VTS + (size_t)((l * 16 + b) * 4 + head) * 128 * SROWS,
              SROWS, TP + b * 16, 1024, 17, head, true, smem, lam, M2, oscale);
  }
  unsigned* ctr = (unsigned*)(p.ws + WS_PAR) + 16 + l;
  while (true) {
    __syncthreads();
    if (tidx(p) == 0) *s_item = (int)atomicAdd(ctr, 1u);
    __syncthreads();
    const int item = *s_item;
    if (item >= 576) break;
    if (item < 64) sgu_sample_unit(p, l, item >> 2, item & 3);
    else { const int j = item - 64; sgu_unit(p, l, j >> 6, (j >> 2) & 15, j & 3, smem); }
  }
}

DI void phase_out(const Params& p, int l, char* smem) {
  const ushort_t* Y = (const ushort_t*)(p.ws + WS_Y);
  const ushort_t* Wt = (const ushort_t*)(p.ws + WS_WOUT) + (size_t)l * DM * DM;
  ushort_t* XB = (ushort_t*)(p.ws + WS_XB);
  float* ssq1 = (float*)(p.ws + WS_SSQ) + TT;
  const int G = gridDim.x;
  constexpr int NTILES = 64 * 4;
  for (int id = blockIdx.x; id < NTILES; id += G) {
    const int mt = id >> 2, ntile = id & 3;
    f32x4 acc[2][2][4][2];
    gemm256(Wt + (size_t)ntile * 256 * 1024, Y + (size_t)mt * 256 * 1024, acc, smem, tidx(p));
    int t_ = tidx(p); asm volatile("" : "+v"(t_));
    const int tid = t_, wid = tid >> 6, lane = tid & 63, wr = wid >> 2, wc = wid & 3, fr = lane & 15, fq = lane >> 4;
#pragma unroll
    for (int bj = 0; bj < 2; ++bj)
#pragma unroll
      for (int n = 0; n < 2; ++n) {
        const int tk = mt * 256 + bj * 128 + wc * 32 + n * 16 + fr;
        float* orow = p.out + (size_t)tk * 1024;
        float s = 0.f;
#pragma unroll
        for (int ai = 0; ai < 2; ++ai)
#pragma unroll
          for (int m = 0; m < 4; ++m) {
            const int c0 = ntile * 256 + ai * 128 + wr * 64 + m * 16 + fq * 4;
            const u32x2 xb = *(const u32x2*)(XB + (size_t)tk * 1024 + c0);
            f32x4 xv = {bflo(xb.x), bfhi(xb.x), bflo(xb.y), bfhi(xb.y)};
            xv += acc[ai][bj][m][n];
            if (l == 1) __builtin_nontemporal_store(xv, (f32x4*)(orow + c0));
            if (l == 0) {
              s += xv.x * xv.x + xv.y * xv.y + xv.z * xv.z + xv.w * xv.w;
              u32x2 o; o.x = pk(xv.x, xv.y); o.y = pk(xv.z, xv.w);
              *(u32x2*)(XB + (size_t)tk * 1024 + c0) = o;
            }
          }
        if (l == 0) {
          s += __shfl_xor(s, 16); s += __shfl_xor(s, 32);
          if (fq == 0) atomicAdd(ssq1 + tk, s);
        }
      }
  }
  for (int it = blockIdx.x; it < 256; it += G) {
    const int tid = tidx(p), wid = tid >> 6, lane = tid & 63, fr = lane & 15, fq = lane >> 4;
    const int sl = it >> 2, tg = it & 3, tt = wid & 3, kh = wid >> 2;
    const int tk = TP + tg * 64 + tt * 16 + fr;
    const ushort_t* wp = Wt + (size_t)(sl * 16 + fr) * 1024 + kh * 512 + fq * 8;
    const ushort_t* yp = Y + (size_t)tk * 1024 + kh * 512 + fq * 8;
    bf16x8 wf[16], yf[16];
#pragma unroll
    for (int q = 0; q < 16; ++q) { wf[q] = *(const bf16x8*)(wp + q * 32); yf[q] = *(const bf16x8*)(yp + q * 32); }
    f32x4 a0 = {0.f, 0.f, 0.f, 0.f};
#pragma unroll
    for (int q = 0; q < 16; ++q) a0 = MFMA16(wf[q], yf[q], a0);
    float* cx = (float*)smem;
    __syncthreads();
    if (kh == 1) *(f32x4*)(cx + (tt * 64 + lane) * 4) = a0;
    __syncthreads();
    if (kh == 0) {
      a0 += *(const f32x4*)(cx + (tt * 64 + lane) * 4);
      const int c0 = sl * 16 + fq * 4;
      const u32x2 xb = *(const u32x2*)(XB + (size_t)tk * 1024 + c0);
      f32x4 xv = {bflo(xb.x), bfhi(xb.x), bflo(xb.y), bfhi(xb.y)};
      xv += a0;
      if (l == 1) *(f32x4*)(p.out + (size_t)tk * 1024 + c0) = xv;
      if (l == 0) {
        float sq = xv.x * xv.x + xv.y * xv.y + xv.z * xv.z + xv.w * xv.w;
        u32x2 o; o.x = pk(xv.x, xv.y); o.y = pk(xv.z, xv.w);
        *(u32x2*)(XB + (size_t)tk * 1024 + c0) = o;
        sq += __shfl_xor(sq, 16); sq += __shfl_xor(sq, 32);
        if (fq == 0) atomicAdd(ssq1 + tk, sq);
      }
    }
  }
}

DI unsigned bar_ld(unsigned* p) { return __hip_atomic_load(p, __ATOMIC_RELAXED, __HIP_MEMORY_SCOPE_AGENT); }
DI unsigned bar_add(unsigned* p, unsigned v) { return __hip_atomic_fetch_add(p, v, __ATOMIC_RELAXED, __HIP_MEMORY_SCOPE_AGENT); }
DI unsigned xcc_id() { return (unsigned)__builtin_amdgcn_s_getreg((3 << 11) | 20) & 0xFu; }

DI void grid_barrier(unsigned* ctr, unsigned target, bool leader) {
  asm volatile("s_waitcnt vmcnt(0)" ::: "memory");
  __syncthreads();
  if (leader) {
    __builtin_amdgcn_fence(__ATOMIC_RELEASE, "agent");
    asm volatile("s_waitcnt vmcnt(0)" ::: "memory");
    bar_add(ctr, 1u);
    while (bar_ld(ctr) < target) __builtin_amdgcn_s_sleep(1);
    __builtin_amdgcn_fence(__ATOMIC_ACQUIRE, "agent");
    asm volatile("s_waitcnt vmcnt(0)" ::: "memory");
  }
  __syncthreads();
}
DI void xcd_barrier(unsigned* bar, unsigned round, const unsigned* s_nxcc, bool leader) {
  asm volatile("s_waitcnt vmcnt(0)" ::: "memory");
  __syncthreads();
  if (leader) {
    const unsigned xcc = xcc_id(), nxcc = *s_nxcc;
    const unsigned mine = bar_ld(bar + 64 + 64 * xcc);
    const unsigned old = bar_add(bar + 1088 + 64 * xcc, 1u);
    if (old + 1u == round * mine) {
      __builtin_amdgcn_fence(__ATOMIC_RELEASE, "agent");
      asm volatile("s_waitcnt vmcnt(0)" ::: "memory");
      bar_add(bar + 2112, 1u);
    }
    while (bar_ld(bar + 2112) < round * nxcc) __builtin_amdgcn_s_sleep(1);
    __builtin_amdgcn_fence(__ATOMIC_ACQUIRE, "agent");
    asm volatile("s_waitcnt vmcnt(0)" ::: "memory");
  }
  __syncthreads();
}

__global__ void __launch_bounds__(512, 1) mega_kernel(Params p0) {
  PW p;
  static_cast<Params&>(p) = p0;
  p.wv = __builtin_amdgcn_readfirstlane((int)(threadIdx.x >> 6));
  const bool leader = (tidx(p) == 0);
  __shared__ __attribute__((aligned(16))) char smem[SMEM_BYTES];
  __shared__ int s_item;
  __shared__ unsigned s_nxcc;
  cg::grid_group grid = cg::this_grid();
  if (p0.ws == nullptr) grid.sync();
  unsigned* bar = (unsigned*)(p.ws + WS_BAR);
  const unsigned G = gridDim.x;
  if (leader) bar_add(bar + 64 + 64 * xcc_id(), 1u);
  phase_prep(p, smem);
  if (leader) {
    unsigned n, tot;
    do {
      n = 0; tot = 0;
      for (int x = 0; x < 16; ++x) { const unsigned c = bar_ld(bar + 64 + 64 * x); tot += c; n += (c != 0u) ? 1u : 0u; }
      if (tot < G) __builtin_amdgcn_s_sleep(1);
    } while (tot < G);
    s_nxcc = n;
  }
  xcd_barrier(bar, 1, &s_nxcc, leader);
#pragma unroll 1
  for (int l = 0; l < 2; ++l) {
    phase_in(p, l, smem);
    xcd_barrier(bar, 3 * l + 2, &s_nxcc, leader);
    phase_mix(p, l, smem, &s_item);
    xcd_barrier(bar, 3 * l + 3, &s_nxcc, leader);
    phase_out(p, l, smem);
    if (l == 0) xcd_barrier(bar, 4, &s_nxcc, leader);
  }
}

extern "C" void kernel_launch(void* const* d_in, const int* in_sizes, int n_in, void* d_out, int out_size, void* d_ws,
                              size_t ws_size, hipStream_t stream) {
  static int grid_blocks = 0;
  if (!grid_blocks) {
    int dev = 0, cus = 0, per_cu = 0;
    (void)hipGetDevice(&dev);
    (void)hipDeviceGetAttribute(&cus, hipDeviceAttributeMultiprocessorCount, dev);
    (void)hipOccupancyMaxActiveBlocksPerMultiprocessor(&per_cu, mega_kernel, 512, 0);
    if (per_cu > 1) per_cu = 1;
    if (per_cu < 1) per_cu = 1;
    grid_blocks = cus * per_cu;
  }
  Params p{};
  p.x_prompt = (const float*)d_in[0]; p.x_sample = (const float*)d_in[1];
  p.cache_k = (const float*)d_in[2]; p.cache_v = (const float*)d_in[3];
  p.norm_g = (const float*)d_in[4]; p.w_in = (const float*)d_in[5];
  p.sgu_norm_g = (const float*)d_in[6]; p.sgu_w = (const float*)d_in[7]; p.sgu_b = (const float*)d_in[8];
  p.q_norm_g = (const float*)d_in[9]; p.k_norm_g = (const float*)d_in[10];
  p.lq1 = (const float*)d_in[11]; p.lk1 = (const float*)d_in[12]; p.lq2 = (const float*)d_in[13]; p.lk2 = (const float*)d_in[14];
  p.subln_g = (const float*)d_in[15]; p.w_out = (const float*)d_in[16];
  p.out = (float*)d_out; p.ws = (char*)d_ws;
  (void)hipMemsetAsync((char*)d_ws + WS_BAR, 0, 16384, stream);
  void* args[] = {&p};
  hipError_t e = hipLaunchCooperativeKernel((void*)mega_kernel, dim3(grid_blocks), dim3(512), args, 0, stream);
  if (e != hipSuccess) fprintf(stderr, "cooperative launch failed: %s (grid %d)\n", hipGetErrorString(e), grid_blocks);
}
```

```cpp
#include <hip/hip_runtime.h>
#include <hip/hip_cooperative_groups.h>
#include <cstdio>
namespace cg = cooperative_groups;

typedef __attribute__((ext_vector_type(8))) short bf16x8;
typedef __attribute__((ext_vector_type(16))) float f32x16;
typedef __attribute__((ext_vector_type(4))) float f32x4;
typedef __bf16 bf16x2_t __attribute__((ext_vector_type(2)));
typedef float f32x2_t __attribute__((ext_vector_type(2)));
typedef unsigned short ushort_t;
typedef unsigned u32x4 __attribute__((ext_vector_type(4)));
typedef unsigned u32x2 __attribute__((ext_vector_type(2)));

#define DI __device__ __forceinline__
#define MFMA32(a, b, c) __builtin_amdgcn_mfma_f32_32x32x16_bf16((a), (b), (c), 0, 0, 0)
#define MFMA16(a, b, c) __builtin_amdgcn_mfma_f32_16x16x32_bf16((a), (b), (c), 0, 0, 0)
#define GLDS(gp, lp) __builtin_amdgcn_global_load_lds((const unsigned*)(gp), (unsigned*)(lp), 16, 0, 0)
#define WAIT_V(n) asm volatile("s_waitcnt vmcnt(" #n ")" ::: "memory")
#define WAIT_L(n) asm volatile("s_waitcnt lgkmcnt(" #n ")" ::: "memory")
#define BAR __builtin_amdgcn_s_barrier()
#define SCHED __builtin_amdgcn_sched_barrier(0)
#define LDS_BARRIER() do { asm volatile("s_waitcnt lgkmcnt(0)" ::: "memory"); __builtin_amdgcn_s_barrier(); asm volatile("" ::: "memory"); } while (0)
#define DSR(dst, addr, imm) asm volatile("ds_read_b128 %0, %1 offset:%2" : "=v"(dst) : "v"(addr), "n"(imm))

constexpr int DM = 1024, NIN = 3584, TP = 16384, TT = 16640;
constexpr int SROWS = 1088;
constexpr float EPS = 1e-6f;
constexpr float LOG2E = 1.4426950408889634f;

constexpr size_t OKP = 17039360, OVP = 33816576, OKS = 50593792, OVS = 50855936, OSGU = 51118080;

constexpr size_t SZ_ACT = (size_t)TT * 512 * 2;
constexpr size_t WS_WIN = 0;
constexpr size_t WS_WOUT = WS_WIN + (size_t)2 * NIN * DM * 2;
constexpr size_t WS_XB = WS_WOUT + (size_t)2 * DM * DM * 2;
constexpr size_t WS_UG = WS_XB + (size_t)TT * 1024 * 2;
constexpr size_t WS_Q = WS_UG + SZ_ACT;
constexpr size_t WS_K = WS_Q + SZ_ACT;
constexpr size_t WS_GB = WS_K + SZ_ACT;
constexpr size_t WS_VNT = WS_GB + SZ_ACT;
constexpr size_t WS_VNS = WS_VNT + (size_t)32 * 128 * 2048 * 2;
constexpr size_t WS_VT = WS_VNS + (size_t)256 * 512 * 2;
constexpr size_t WS_Y = WS_VT + (size_t)32 * 128 * 2048 * 2;
constexpr size_t WS_KSB = WS_Y + (size_t)TT * 1024 * 2;
constexpr size_t WS_VTS = WS_KSB + (size_t)2 * 16 * SROWS * 512 * 2;
constexpr size_t WS_SSQ = WS_VTS + (size_t)2 * 16 * 4 * 128 * SROWS * 2;
constexpr size_t WS_PAR = WS_SSQ + (size_t)2 * TT * 4;
constexpr size_t WS_BAR = WS_PAR + 256;
constexpr size_t WS_END = WS_BAR + 16384;
static_assert(WS_END <= (size_t)256 * 1024 * 1024, "workspace too large");

constexpr int EX_OFF = 131072;
constexpr int RS_OFF = 131072 + 4096;
constexpr int SMEM_BYTES = 131072 + 4096 + 1024 + 64;

struct Params {
  const float* x_prompt; const float* x_sample; const float* cache_k; const float* cache_v;
  const float* norm_g; const float* w_in; const float* sgu_norm_g; const float* sgu_w; const float* sgu_b;
  const float* q_norm_g; const float* k_norm_g; const float* lq1; const float* lk1; const float* lq2; const float* lk2;
  const float* subln_g; const float* w_out;
  float* out; char* ws;
};
struct PW : Params { int wv; };
__device__ __forceinline__ int tidx(const Params& p) {
  int lane;
  asm volatile("v_mbcnt_lo_u32_b32 %0, -1, 0\n\tv_mbcnt_hi_u32_b32 %0, -1, %0" : "=v"(lane));
  return static_cast<const PW&>(p).wv * 64 + lane;
}

DI unsigned pk(float a, float b) {
  f32x2_t v = {a, b};
  bf16x2_t r = __builtin_convertvector(v, bf16x2_t);
  return __builtin_bit_cast(unsigned, r);
}
DI float bflo(unsigned u) { return __uint_as_float(u << 16); }
DI float bfhi(unsigned u) { return __uint_as_float(u & 0xffff0000u); }
DI float silu(float v) { return v * __builtin_amdgcn_rcpf(1.f + __expf(-v)); }
DI u32x4 pk8(f32x4 a, f32x4 b) {
  u32x4 r; r.x = pk(a.x, a.y); r.y = pk(a.z, a.w); r.z = pk(b.x, b.y); r.w = pk(b.z, b.w); return r;
}
DI int kperm(int k16) { return 8 * ((k16 >> 2) & 1) + (k16 & 3) + 4 * (k16 >> 3); }
DI int kinv(int p16) { return 8 * ((p16 & 7) >> 2) + 4 * (p16 >> 3) + (p16 & 3); }

struct TTRegs { f32x4 v[2]; float g[2]; };
DI void tt_load(TTRegs& R, const float* src, size_t sstride, const float* g, int t) {
#pragma unroll
  for (int i = 0; i < 2; ++i) {
    const int f = t + 512 * i, r = f >> 4, c4 = f & 15;
    R.v[i] = __builtin_nontemporal_load((const f32x4*)(src + (size_t)r * sstride + c4 * 4));
    R.g[i] = g ? g[r] : 1.f;
  }
}
DI void tt_to_lds(const TTRegs& R, float* tile, int t) {
#pragma unroll
  for (int i = 0; i < 2; ++i) {
    const int f = t + 512 * i, r = f >> 4, c4 = f & 15;
    float* tp = tile + r * 65 + c4 * 4;
    tp[0] = R.v[i].x * R.g[i]; tp[1] = R.v[i].y * R.g[i]; tp[2] = R.v[i].z * R.g[i]; tp[3] = R.v[i].w * R.g[i];
  }
}
DI void tt_store(ushort_t* dst, size_t dstride, bool perm, const float* tile, int t) {
  const int c = t >> 3, k8 = t & 7;
  float v[8];
#pragma unroll
  for (int e = 0; e < 8; ++e) {
    const int p = k8 * 8 + e;
    const int r = perm ? ((p & ~15) + kinv(p & 15)) : p;
    v[e] = tile[r * 65 + c];
  }
  u32x4 o; o.x = pk(v[0], v[1]); o.y = pk(v[2], v[3]); o.z = pk(v[4], v[5]); o.w = pk(v[6], v[7]);
  if (perm) __builtin_nontemporal_store(o, (u32x4*)(dst + (size_t)c * dstride + k8 * 8));
  else *(u32x4*)(dst + (size_t)c * dstride + k8 * 8) = o;
}

DI int src_section(int sec) {
  const int nt = sec >> 1, ai = sec & 1;
  if (nt < 4) return ai ? 8 + nt : nt;
  if (nt < 6) return 4 + 2 * (nt - 4) + ai;
  if (nt < 10) return ai ? 16 + (nt - 6) : 12 + (nt - 6);
  return ai ? 24 + (nt - 10) : 20 + (nt - 10);
}

DI void phase_prep(const Params& p, char* smem) {
  float* tile = (float*)smem;
  int t_ = tidx(p); asm volatile("" : "+v"(t_));
  const int t = t_, lane = t & 63, w = t >> 6;
  const int G = gridDim.x;
  {
    struct TJob { const float* src; size_t ss; ushort_t* dst; size_t ds; const float* g; bool perm; };
    auto job = [&](int item) {
      TJob J;
      if (item < 2304) {
        const int l = item / 1152;
        int idx = item % 1152;
        if (idx < 896) {
          const int kt = idx / 56, db = idx % 56;
          const int sb = src_section(db >> 1) * 2 + (db & 1);
          J.src = p.w_in + (size_t)l * DM * NIN + (size_t)(kt * 64) * NIN + sb * 64; J.ss = NIN;
          J.dst = (ushort_t*)(p.ws + WS_WIN) + (size_t)l * NIN * DM + (size_t)(db * 64) * DM + kt * 64; J.ds = DM;
          J.g = p.norm_g + l * DM + kt * 64; J.perm = false;
        } else {
          idx -= 896;
          const int kt = idx / 16, nb = idx % 16;
          J.src = p.w_out + (size_t)l * DM * DM + (size_t)(kt * 64) * DM + nb * 64; J.ss = DM;
          J.dst = (ushort_t*)(p.ws + WS_WOUT) + (size_t)l * DM * DM + (size_t)(nb * 64) * DM + kt * 64; J.ds = DM;
          J.g = nullptr; J.perm = false;
        }
      } else {
        const int it = item - 2304;
        const int dh = it & 1, head = (it >> 1) & 3, pt = (it >> 3) & 15, lb = it >> 7;
        J.src = p.cache_v + ((size_t)lb * 1024 + pt * 64) * 512 + head * 128 + dh * 64; J.ss = 512;
        J.dst = (ushort_t*)(p.ws + WS_VTS) + ((size_t)(lb * 4 + head) * 128 + dh * 64) * SROWS + pt * 64; J.ds = SROWS;
        J.g = nullptr; J.perm = true;
      }
      return J;
    };
    constexpr int NJ = 2304 + 4096;
    TTRegs R[4];
    TJob J[4];
    int item = blockIdx.x * 4;
    if (item < NJ) {
#pragma unroll
      for (int u = 0; u < 4; ++u) { J[u] = job(item + u); tt_load(R[u], J[u].src, J[u].ss, J[u].g, t); }
    }
    while (item < NJ) {
      __syncthreads();
#pragma unroll
      for (int u = 0; u < 4; ++u) tt_to_lds(R[u], tile + u * 4160, t);
      __syncthreads();
      TJob Jc[4];
#pragma unroll
      for (int u = 0; u < 4; ++u) Jc[u] = J[u];
      const int nxt = item + G * 4;
      if (nxt < NJ) {
#pragma unroll
        for (int u = 0; u < 4; ++u) { J[u] = job(nxt + u); tt_load(R[u], J[u].src, J[u].ss, J[u].g, t); }
      }
#pragma unroll
      for (int u = 0; u < 4; ++u) tt_store(Jc[u].dst, Jc[u].ds, Jc[u].perm, tile + u * 4160, t);
      item = nxt;
    }
  }
  {
    ushort_t* XB = (ushort_t*)(p.ws + WS_XB);
    float* ssq = (float*)(p.ws + WS_SSQ);
    for (int row0 = (blockIdx.x * 8 + w) * 4; row0 < TT; row0 += G * 32) {
      f32x4 v[4][4];
#pragma unroll
      for (int rr = 0; rr < 4; ++rr) {
        const int row = row0 + rr;
        const float* xr = (row < TP) ? p.x_prompt + (size_t)row * 1024 : p.x_sample + (size_t)(row - TP) * 1024;
#pragma unroll
        for (int i = 0; i < 4; ++i) v[rr][i] = __builtin_nontemporal_load((const f32x4*)(xr + i * 256 + lane * 4));
      }
#pragma unroll
      for (int rr = 0; rr < 4; ++rr) {
        const int row = row0 + rr;
        float sq = 0.f;
#pragma unroll
        for (int i = 0; i < 4; ++i) {
          const f32x4 a = v[rr][i];
          sq += a.x * a.x + a.y * a.y + a.z * a.z + a.w * a.w;
          u32x2 o; o.x = pk(a.x, a.y); o.y = pk(a.z, a.w);
          *(u32x2*)(XB + (size_t)row * 1024 + i * 256 + lane * 4) = o;
        }
#pragma unroll
        for (int m = 1; m < 64; m <<= 1) sq += __shfl_xor(sq, m);
        if (lane == 0) { ssq[row] = sq; ssq[TT + row] = 0.f; }
      }
    }
  }
  {
    ushort_t* KSB = (ushort_t*)(p.ws + WS_KSB);
    for (int row0 = (blockIdx.x * 8 + w) * 4; row0 < 32768; row0 += G * 32) {
      f32x4 a[4], b4[4];
#pragma unroll
      for (int rr = 0; rr < 4; ++rr) {
        const float* sr = p.cache_k + (size_t)(row0 + rr) * 512 + lane * 8;
        a[rr] = __builtin_nontemporal_load((const f32x4*)sr); b4[rr] = __builtin_nontemporal_load((const f32x4*)(sr + 4));
      }
#pragma unroll
      for (int rr = 0; rr < 4; ++rr) {
        const int row = row0 + rr, lb = row >> 10, pos = row & 1023;
        __builtin_nontemporal_store(pk8(a[rr], b4[rr]), (u32x4*)(KSB + ((size_t)lb * SROWS + pos) * 512 + lane * 8));
      }
    }
  }
  if (blockIdx.x == 0 && w == 0) {
#pragma unroll
    for (int l = 0; l < 2; ++l) {
      float s1 = p.lq1[l * 64 + lane] * p.lk1[l * 64 + lane];
      float s2 = p.lq2[l * 64 + lane] * p.lk2[l * 64 + lane];
      float mq = fabsf(p.q_norm_g[l * 64 + lane]);
      float mk = fabsf(p.k_norm_g[l * 64 + lane]);
#pragma unroll
      for (int m = 1; m < 64; m <<= 1) {
        s1 += __shfl_xor(s1, m); s2 += __shfl_xor(s2, m);
        mq = fmaxf(mq, __shfl_xor(mq, m)); mk = fmaxf(mk, __shfl_xor(mk, m));
      }
      if (lane == 0) {
        const float lam_init = 0.8f - 0.6f * expf(-0.3f * (float)l);
        float* par = (float*)(p.ws + WS_PAR);
        par[l * 4 + 0] = expf(s1) - expf(s2) + lam_init;
        par[l * 4 + 1] = 8.f * mq * mk * 1.03f * LOG2E + 0.25f;
        par[l * 4 + 2] = 1.f - lam_init;
        atomicExch((unsigned*)(p.ws + WS_PAR) + 16 + l, 0u);
      }
    }
  }
}

DI int lds_byte(int r, int c) {
  const int st = (r >> 4) * 2 + (c >> 5), rr = r & 15, cc = c & 31, ob = rr * 64 + cc * 2;
  return st * 1024 + (ob ^ (((ob >> 9) & 1) << 5));
}
DI void stage_rc(int b, int& R, int& C) {
  const int st = b / 1024, sb = b % 1024, swz = sb ^ (((sb >> 9) & 1) << 5);
  R = (st >> 1) * 16 + swz / 64; C = (st & 1) * 32 + (swz % 64) / 2;
}

DI void gemm256(const ushort_t* A, const ushort_t* Bt, f32x4 (&acc)[2][2][4][2], char* shmc, int tid_in) {
  constexpr int K = 1024, BK = 64, HALF = 128, HT = HALF * BK;
  ushort_t* shm = (ushort_t*)shmc;
#define SA(b, h) (shm + ((b) * 2 + (h)) * HT)
#define SB(b, h) (shm + (4 + (b) * 2 + (h)) * HT)
#define STAGE(P, BASE, br, kt) do { const long _g = (long)(br) * K + (long)(kt) * BK; \
    _Pragma("unroll") for (int _i = 0; _i < 2; ++_i) { const int _b = tid * 16 + _i * 8192; int _r, _c; stage_rc(_b, _r, _c); \
      GLDS(BASE + _g + (long)_r * K + _c, (char*)(P) + _b); } } while (0)
#define LDA(dst, b, h) do { const unsigned _a = a_base + ((b) * 2 + (h)) * 16384u; \
    DSR(dst[0][0], _a, 0); DSR(dst[0][1], _a, 1024); DSR(dst[1][0], _a, 2048); DSR(dst[1][1], _a, 3072); \
    DSR(dst[2][0], _a, 4096); DSR(dst[2][1], _a, 5120); DSR(dst[3][0], _a, 6144); DSR(dst[3][1], _a, 7168); } while (0)
#define LDB(dst, b, h) do { const unsigned _a = b_base + (4 + (b) * 2 + (h)) * 16384u; \
    DSR(dst[0][0], _a, 0); DSR(dst[0][1], _a, 1024); DSR(dst[1][0], _a, 2048); DSR(dst[1][1], _a, 3072); } while (0)
#define TIE(Bx) asm volatile("s_waitcnt lgkmcnt(0)" : "+v"(At[0][0]), "+v"(At[0][1]), "+v"(At[1][0]), "+v"(At[1][1]), \
    "+v"(At[2][0]), "+v"(At[2][1]), "+v"(At[3][0]), "+v"(At[3][1]), "+v"(Bx[0][0]), "+v"(Bx[0][1]), "+v"(Bx[1][0]), "+v"(Bx[1][1]))
#define MMA(ai, bj, At_, Bt_) do { __builtin_amdgcn_s_setprio(1); \
    _Pragma("unroll") for (int m = 0; m < 4; ++m) _Pragma("unroll") for (int n = 0; n < 2; ++n) _Pragma("unroll") for (int k = 0; k < 2; ++k) \
      acc[ai][bj][m][n] = MFMA16(At_[m][k], Bt_[n][k], acc[ai][bj][m][n]); \
    __builtin_amdgcn_s_setprio(0); } while (0)

  int tid_ = tid_in; asm volatile("" : "+v"(tid_));
  const int tid = tid_;
  const int wid = tid >> 6, lane = tid & 63, wr = wid >> 2, wc = wid & 3, fr = lane & 15, fq = lane >> 4;
  const unsigned lds0 = (unsigned)(size_t)shmc;
  const unsigned a_base = lds0 + wr * 8192 + lds_byte(fr, fq * 8);
  const unsigned b_base = lds0 + wc * 4096 + lds_byte(fr, fq * 8);
#pragma unroll
  for (int a = 0; a < 2; ++a)
#pragma unroll
    for (int b = 0; b < 2; ++b)
#pragma unroll
      for (int m = 0; m < 4; ++m)
#pragma unroll
        for (int n = 0; n < 2; ++n) acc[a][b][m][n] = (f32x4){0.f, 0.f, 0.f, 0.f};
  bf16x8 At[4][2], B0[2][2], B1[2][2];
  constexpr int nt = K / BK;
  STAGE(SB(0, 0), Bt, 0, 0); STAGE(SA(0, 0), A, 0, 0);
  STAGE(SB(0, 1), Bt, HALF, 0); STAGE(SA(0, 1), A, HALF, 0);
  if (wr == 1) BAR;
  WAIT_V(4); BAR;
  STAGE(SB(1, 0), Bt, 0, 1); STAGE(SA(1, 0), A, 0, 1); STAGE(SB(1, 1), Bt, HALF, 1);
  WAIT_V(6); BAR;
#pragma unroll 1
  for (int t = 0; t < nt - 2; t += 2) {
    LDB(B0, 0, 0); SCHED; LDA(At, 0, 0); STAGE(SA(1, 1), A, HALF, t + 1);
    WAIT_L(8); BAR; TIE(B0); MMA(0, 0, At, B0); BAR; SCHED;
    LDB(B1, 0, 1); STAGE(SB(0, 0), Bt, 0, t + 2);
    BAR; TIE(B1); MMA(0, 1, At, B1); BAR;
    LDA(At, 0, 1); STAGE(SA(0, 0), A, 0, t + 2);
    BAR; TIE(B0); MMA(1, 0, At, B0); BAR; SCHED;
    STAGE(SB(0, 1), Bt, HALF, t + 2);
    WAIT_V(6); BAR; MMA(1, 1, At, B1); BAR;
    LDB(B0, 1, 0); SCHED; LDA(At, 1, 0); STAGE(SA(0, 1), A, HALF, t + 2);
    WAIT_L(8); BAR; TIE(B0); MMA(0, 0, At, B0); BAR; SCHED;
    LDB(B1, 1, 1); STAGE(SB(1, 0), Bt, 0, t + 3);
    BAR; TIE(B1); MMA(0, 1, At, B1); BAR;
    LDA(At, 1, 1); STAGE(SA(1, 0), A, 0, t + 3);
    BAR; TIE(B0); MMA(1, 0, At, B0); BAR; SCHED;
    STAGE(SB(1, 1), Bt, HALF, t + 3);
    WAIT_V(6); BAR; MMA(1, 1, At, B1); BAR;
  }
  { LDB(B0, 0, 0); LDA(At, 0, 0); STAGE(SA(1, 1), A, HALF, nt - 1);
    BAR; TIE(B0); MMA(0, 0, At, B0); BAR;
    LDB(B1, 0, 1); BAR; TIE(B1); MMA(0, 1, At, B1); BAR;
    LDA(At, 0, 1); WAIT_V(4); BAR; TIE(B0); MMA(1, 0, At, B0); MMA(1, 1, At, B1); BAR; }
  { LDB(B0, 1, 0); LDA(At, 1, 0); WAIT_V(2); BAR; TIE(B0); MMA(0, 0, At, B0); BAR;
    LDB(B1, 1, 1); WAIT_V(0); BAR; TIE(B1); MMA(0, 1, At, B1); BAR;
    LDA(At, 1, 1); BAR; TIE(B0); MMA(1, 0, At, B0); MMA(1, 1, At, B1); BAR; }
  if (wr == 0) BAR;
#undef SA
#undef SB
#undef STAGE
#undef LDA
#undef LDB
#undef TIE
#undef MMA
}

DI void phase_in(const Params& p, int l, char* smem) {
  ushort_t* UG = (ushort_t*)(p.ws + WS_UG);
  ushort_t* Qb = (ushort_t*)(p.ws + WS_Q);
  ushort_t* Kb = (ushort_t*)(p.ws + WS_K);
  ushort_t* GB = (ushort_t*)(p.ws + WS_GB);
  ushort_t* VNT = (ushort_t*)(p.ws + WS_VNT);
  ushort_t* VNS = (ushort_t*)(p.ws + WS_VNS);
  ushort_t* VT = (ushort_t*)(p.ws + WS_VT);
  ushort_t* KSB = (ushort_t*)(p.ws + WS_KSB);
  ushort_t* VTS = (ushort_t*)(p.ws + WS_VTS);
  const ushort_t* XB = (const ushort_t*)(p.ws + WS_XB);
  const float* ssq = (const float*)(p.ws + WS_SSQ) + (size_t)l * TT;
  const ushort_t* Wt = (const ushort_t*)(p.ws + WS_WIN) + (size_t)l * NIN * DM;
  float* ex = (float*)(smem + EX_OFF);
  const int G = gridDim.x;
  constexpr int NTILES = 65 * 14;

  for (int id = blockIdx.x; id < NTILES; id += G) {
    int mt, ntile;
    if (id >= 242 && id < 256) { mt = 64; ntile = id - 242; }
    else {
      const int id2 = (id < 242) ? id : id - 14, grp = id2 / (8 * 14), rem = id2 % (8 * 14);
      mt = grp * 8 + (rem & 7); ntile = rem >> 3;
    }
    const float ssq_mine = ssq[mt * 256 + (tidx(p) & 255)];
    f32x4 acc[2][2][4][2];
    gemm256(Wt + (size_t)ntile * 256 * 1024, XB + (size_t)mt * 256 * 1024, acc, smem, tidx(p));

    int t_ = tidx(p); asm volatile("" : "+v"(t_));
    const int tid = t_, wid = tid >> 6, lane = tid & 63, wr = wid >> 2, wc = wid & 3, fr = lane & 15, fq = lane >> 4;
    const bool samp = (mt == 64);
    float* rsl = (float*)(smem + RS_OFF);
    if (tid < 256) rsl[tid] = rsqrtf(ssq_mine * (1.f / 1024.f) + EPS);
    LDS_BARRIER();
    float rs[2][2]; int tok[2][2];
#pragma unroll
    for (int bj = 0; bj < 2; ++bj)
#pragma unroll
      for (int n = 0; n < 2; ++n) {
        const int tl_ = bj * 128 + wc * 32 + n * 16 + fr;
        tok[bj][n] = mt * 256 + tl_;
        rs[bj][n] = rsl[tl_];
      }
    const int sc00 = wr * 64 + fq * 4;

    if (!samp) {
      const int pb = (mt * 256) >> 11, tt0 = (mt * 256) & 2047;
      int tokl[2][2];
#pragma unroll
      for (int bj = 0; bj < 2; ++bj)
#pragma unroll
        for (int n = 0; n < 2; ++n) tokl[bj][n] = bj * 128 + wc * 32 + n * 16 + fr;
      const bool oddl = (fr & 1) != 0;
      auto store_rows = [&](ushort_t* gdst) {
        LDS_BARRIER();
#pragma unroll
        for (int i = 0; i < 8; ++i) {
          const int idx = tid + 512 * i, row = idx >> 4, c = idx & 15;
          const u32x4 v = *(const u32x4*)(smem + row * 272 + c * 16);
          *(u32x4*)(gdst + (size_t)row * 512 + c * 8) = v;
        }
        LDS_BARRIER();
      };
      auto store_tr = [&](ushort_t* gdst) {
        LDS_BARRIER();
#pragma unroll
        for (int i = 0; i < 8; ++i) {
          const int idx = tid + 512 * i, d = idx >> 5, c = idx & 31;
          const u32x4 v = *(const u32x4*)(smem + d * 528 + c * 16);
          *(u32x4*)(gdst + (size_t)d * 2048 + c * 8) = v;
        }
        LDS_BARRIER();
      };
      auto tr_write = [&](int pos, int sc0, unsigned o0, unsigned o1) {
        const unsigned snd = oddl ? o0 : o1;
        const unsigned rcv = (unsigned)__builtin_amdgcn_mov_dpp((int)snd, 0xB1, 0xF, 0xF, true);
        unsigned w0, w1; int d;
        if (!oddl) { w0 = (o0 & 0xffffu) | (rcv << 16); w1 = (o0 >> 16) | (rcv & 0xffff0000u); d = sc0; }
        else { w0 = (rcv & 0xffffu) | (o1 << 16); w1 = (rcv >> 16) | (o1 & 0xffff0000u); d = sc0 + 2; }
        char* ip = smem + d * 528 + (pos >> 1) * 4;
        *(unsigned*)ip = w0; *(unsigned*)(ip + 528) = w1;
      };
      if (ntile < 4) {
        const int cb = ntile * 128;
#pragma unroll
        for (int bj = 0; bj < 2; ++bj)
#pragma unroll
          for (int n = 0; n < 2; ++n) {
            const float r = rs[bj][n];
#pragma unroll
            for (int m = 0; m < 4; ++m) {
              const f32x4 u = acc[0][bj][m][n] * r, g = acc[1][bj][m][n] * r;
              u32x2 o; o.x = pk(u.x * silu(g.x), u.y * silu(g.y)); o.y = pk(u.z * silu(g.z), u.w * silu(g.w));
              *(u32x2*)(smem + tokl[bj][n] * 272 + (sc00 + m * 16) * 2) = o;
            }
          }
        store_rows(UG + (size_t)(mt * 256) * 512 + cb);
      } else if (ntile < 6) {
        float part[2][2][2];
#pragma unroll
        for (int ai = 0; ai < 2; ++ai)
#pragma unroll
          for (int bj = 0; bj < 2; ++bj)
#pragma unroll
            for (int n = 0; n < 2; ++n) {
              float sq = 0.f;
#pragma unroll
              for (int m = 0; m < 4; ++m) {
                const f32x4 v = acc[ai][bj][m][n];
                sq += v.x * v.x + v.y * v.y + v.z * v.z + v.w * v.w;
              }
              sq += __shfl_xor(sq, 16); sq += __shfl_xor(sq, 32);
              part[ai][bj][n] = sq;
              if (fq == 0) ex[((wid * 2 + ai) * 4 + bj * 2 + n) * 16 + fr] = sq;
            }
        __syncthreads();
#pragma unroll
        for (int ai = 0; ai < 2; ++ai) {
          const int head = 2 * (ntile - 4) + ai;
          const float* gp = p.sgu_norm_g + l * 512 + head * 128;
#pragma unroll
          for (int bj = 0; bj < 2; ++bj)
#pragma unroll
            for (int n = 0; n < 2; ++n) {
              const float r = rs[bj][n];
              const float tot = (part[ai][bj][n] + ex[(((wid ^ 4) * 2 + ai) * 4 + bj * 2 + n) * 16 + fr]) * r * r;
              const float rn = rsqrtf(tot * (1.f / 128.f) + EPS) * r;
#pragma unroll
              for (int m = 0; m < 4; ++m) {
                const int sc0 = sc00 + m * 16;
                const f32x4 v = acc[ai][bj][m][n];
                const f32x4 gg = *(const f32x4*)(gp + sc0);
                tr_write(tokl[bj][n], sc0, pk(v.x * rn * gg.x, v.y * rn * gg.y), pk(v.z * rn * gg.z, v.w * rn * gg.w));
              }
            }
          store_tr(VNT + ((size_t)(pb * 4 + head) * 128) * 2048 + tt0);
        }
      } else if (ntile < 10) {
        const int head = ntile - 6, cb = head * 128;
#pragma unroll
        for (int ai = 0; ai < 2; ++ai) {
          const float* gp = (ai == 0 ? p.q_norm_g : p.k_norm_g) + l * 64;
#pragma unroll
          for (int bj = 0; bj < 2; ++bj)
#pragma unroll
            for (int n = 0; n < 2; ++n) {
              float sq = 0.f;
#pragma unroll
              for (int m = 0; m < 4; ++m) {
                const f32x4 v = acc[ai][bj][m][n];
                sq += v.x * v.x + v.y * v.y + v.z * v.z + v.w * v.w;
              }
              sq += __shfl_xor(sq, 16); sq += __shfl_xor(sq, 32);
              const float r = rs[bj][n];
              const float rn = rsqrtf(sq * r * r * (1.f / 64.f) + EPS) * r * (ai == 0 ? 0.125f * LOG2E : 1.f);
              const int tk = tok[bj][n];
#pragma unroll
              for (int m = 0; m < 4; ++m) {
                const int sc0 = sc00 + m * 16;
                const f32x4 gg = *(const f32x4*)(gp + fq * 4 + m * 16);
                const f32x4 v = acc[ai][bj][m][n] * rn * gg;
                u32x2 o; o.x = pk(v.x, v.y); o.y = pk(v.z, v.w);
                if (ai == 1) __builtin_nontemporal_store(v, (f32x4*)(p.out + OKP + (size_t)l * 8388608 + (size_t)tk * 512 + cb + sc0));
                *(u32x2*)(smem + tokl[bj][n] * 272 + sc0 * 2) = o;
              }
            }
          store_rows((ai == 0 ? Qb : Kb) + (size_t)(mt * 256) * 512 + cb);
        }
      } else {
        const int head = ntile - 10, cb = head * 128;
#pragma unroll
        for (int bj = 0; bj < 2; ++bj)
#pragma unroll
          for (int n = 0; n < 2; ++n) {
            const float r = rs[bj][n];
            const int tk = tok[bj][n];
            const int tl = tokl[bj][n];
            const int pos = (tl & ~15) + kperm(tl & 15);
#pragma unroll
            for (int m = 0; m < 4; ++m) {
              const int sc0 = sc00 + m * 16;
              const f32x4 v = acc[0][bj][m][n] * r;
              __builtin_nontemporal_store(v, (f32x4*)(p.out + OVP + (size_t)l * 8388608 + (size_t)tk * 512 + cb + sc0));
              tr_write(pos, sc0, pk(v.x, v.y), pk(v.z, v.w));
            }
          }
        store_tr(VT + ((size_t)(pb * 4 + head) * 128) * 2048 + tt0);
#pragma unroll
        for (int bj = 0; bj < 2; ++bj)
#pragma unroll
          for (int n = 0; n < 2; ++n) {
            const float r = rs[bj][n];
#pragma unroll
            for (int m = 0; m < 4; ++m) {
              const f32x4 g = acc[1][bj][m][n] * r;
              u32x2 o; o.x = pk(silu(g.x), silu(g.y)); o.y = pk(silu(g.z), silu(g.w));
              *(u32x2*)(smem + tokl[bj][n] * 272 + (sc00 + m * 16) * 2) = o;
            }
          }
        store_rows(GB + (size_t)(mt * 256) * 512 + cb);
      }
      continue;
    }
    if (ntile < 4) {
      const int cb = ntile * 128;
#pragma unroll
      for (int bj = 0; bj < 2; ++bj)
#pragma unroll
        for (int n = 0; n < 2; ++n) {
          const float r = rs[bj][n];
#pragma unroll
          for (int m = 0; m < 4; ++m) {
            const f32x4 u = acc[0][bj][m][n] * r, g = acc[1][bj][m][n] * r;
            u32x2 o; o.x = pk(u.x * silu(g.x), u.y * silu(g.y)); o.y = pk(u.z * silu(g.z), u.w * silu(g.w));
            *(u32x2*)(UG + (size_t)tok[bj][n] * 512 + cb + sc00 + m * 16) = o;
          }
        }
    } else if (ntile < 6) {
      float part[2][2][2];
#pragma unroll
      for (int ai = 0; ai < 2; ++ai)
#pragma unroll
        for (int bj = 0; bj < 2; ++bj)
#pragma unroll
          for (int n = 0; n < 2; ++n) {
            float s = 0.f;
#pragma unroll
            for (int m = 0; m < 4; ++m) {
              const f32x4 v = acc[ai][bj][m][n];
              s += v.x * v.x + v.y * v.y + v.z * v.z + v.w * v.w;
            }
            s += __shfl_xor(s, 16); s += __shfl_xor(s, 32);
            part[ai][bj][n] = s;
            if (fq == 0) ex[((wid * 2 + ai) * 4 + bj * 2 + n) * 16 + fr] = s;
          }
      __syncthreads();
#pragma unroll
      for (int ai = 0; ai < 2; ++ai) {
        const int head = 2 * (ntile - 4) + ai;
        const int cb = head * 128;
        const float* gp = p.sgu_norm_g + l * 512 + cb;
#pragma unroll
        for (int bj = 0; bj < 2; ++bj)
#pragma unroll
          for (int n = 0; n < 2; ++n) {
            const float r = rs[bj][n];
            const float tot = (part[ai][bj][n] + ex[(((wid ^ 4) * 2 + ai) * 4 + bj * 2 + n) * 16 + fr]) * r * r;
            const float rn = rsqrtf(tot * (1.f / 128.f) + EPS) * r;
            const int tk = tok[bj][n];
#pragma unroll
            for (int m = 0; m < 4; ++m) {
              const int sc0 = sc00 + m * 16;
              const f32x4 v = acc[ai][bj][m][n];
              const f32x4 gg = *(const f32x4*)(gp + sc0);
              const unsigned o0 = pk(v.x * rn * gg.x, v.y * rn * gg.y), o1 = pk(v.z * rn * gg.z, v.w * rn * gg.w);
              if (samp) {
                const int rs_ = tk - TP;
                *(f32x4*)(p.out + OSGU + (size_t)l * 131072 + (size_t)rs_ * 512 + cb + sc0) = v * r;
                u32x2 o; o.x = o0; o.y = o1;
                *(u32x2*)(VNS + (size_t)rs_ * 512 + cb + sc0) = o;
              } else {
                const int b = tk >> 11, tt = tk & 2047;
                ushort_t* vb = VNT + ((size_t)(b * 4 + head) * 128 + sc0) * 2048 + tt;
                vb[0] = (ushort_t)(o0 & 0xffff); vb[2048] = (ushort_t)(o0 >> 16);
                vb[4096] = (ushort_t)(o1 & 0xffff); vb[6144] = (ushort_t)(o1 >> 16);
              }
            }
          }
      }
      __syncthreads();
    } else if (ntile < 10) {
      const int head = ntile - 6, cb = head * 128;
#pragma unroll
      for (int ai = 0; ai < 2; ++ai) {
        const float* gp = (ai == 0 ? p.q_norm_g : p.k_norm_g) + l * 64;
#pragma unroll
        for (int bj = 0; bj < 2; ++bj)
#pragma unroll
          for (int n = 0; n < 2; ++n) {
            float s = 0.f;
#pragma unroll
            for (int m = 0; m < 4; ++m) {
              const f32x4 v = acc[ai][bj][m][n];
              s += v.x * v.x + v.y * v.y + v.z * v.z + v.w * v.w;
            }
            s += __shfl_xor(s, 16); s += __shfl_xor(s, 32);
            const float r = rs[bj][n];
            const float rn = rsqrtf(s * r * r * (1.f / 64.f) + EPS) * r * (ai == 0 ? 0.125f * LOG2E : 1.f);
            const int tk = tok[bj][n];
#pragma unroll
            for (int m = 0; m < 4; ++m) {
              const int sc0 = sc00 + m * 16;
              const f32x4 gg = *(const f32x4*)(gp + fq * 4 + m * 16);
              const f32x4 v = acc[ai][bj][m][n] * rn * gg;
              u32x2 o; o.x = pk(v.x, v.y); o.y = pk(v.z, v.w);
              if (ai == 0) {
                *(u32x2*)(Qb + (size_t)tk * 512 + cb + sc0) = o;
              } else if (samp) {
                const int rs_ = tk - TP, b = rs_ >> 4, tq = rs_ & 15;
                *(f32x4*)(p.out + OKS + (size_t)l * 131072 + (size_t)rs_ * 512 + cb + sc0) = v;
                *(u32x2*)(KSB + ((size_t)(l * 16 + b) * SROWS + 1024 + tq) * 512 + cb + sc0) = o;
              } else {
                *(f32x4*)(p.out + OKP + (size_t)l * 8388608 + (size_t)tk * 512 + cb + sc0) = v;
                *(u32x2*)(Kb + (size_t)tk * 512 + cb + sc0) = o;
              }
            }
          }
      }
    } else {
      const int head = ntile - 10, cb = head * 128;
#pragma unroll
      for (int bj = 0; bj < 2; ++bj)
#pragma unroll
        for (int n = 0; n < 2; ++n) {
          const float r = rs[bj][n];
          const int tk = tok[bj][n];
#pragma unroll
          for (int m = 0; m < 4; ++m) {
            const int sc0 = sc00 + m * 16;
            const f32x4 v = acc[0][bj][m][n] * r;
            const unsigned o0 = pk(v.x, v.y), o1 = pk(v.z, v.w);
            if (samp) {
              const int rs_ = tk - TP, b = rs_ >> 4, tq = rs_ & 15;
              *(f32x4*)(p.out + OVS + (size_t)l * 131072 + (size_t)rs_ * 512 + cb + sc0) = v;
              ushort_t* vb = VTS + ((size_t)((l * 16 + b) * 4 + head) * 128 + sc0) * SROWS + 1024 + kperm(tq);
              vb[0] = (ushort_t)(o0 & 0xffff); vb[SROWS] = (ushort_t)(o0 >> 16);
              vb[2 * SROWS] = (ushort_t)(o1 & 0xffff); vb[3 * SROWS] = (ushort_t)(o1 >> 16);
            } else {
              *(f32x4*)(p.out + OVP + (size_t)l * 8388608 + (size_t)tk * 512 + cb + sc0) = v;
              const int b = tk >> 11, tt = tk & 2047;
              ushort_t* vb = VT + ((size_t)(b * 4 + head) * 128 + sc0) * 2048 + (tt & ~15) + kperm(tt & 15);
              vb[0] = (ushort_t)(o0 & 0xffff); vb[2048] = (ushort_t)(o0 >> 16);
              vb[4096] = (ushort_t)(o1 & 0xffff); vb[6144] = (ushort_t)(o1 >> 16);
            }
            const f32x4 g = acc[1][bj][m][n] * r;
            u32x2 o; o.x = pk(silu(g.x), silu(g.y)); o.y = pk(silu(g.z), silu(g.w));
            *(u32x2*)(GB + (size_t)tk * 512 + cb + sc0) = o;
          }
        }
    }
  }
}

DI void attn_unit(const Params& p, int l, const ushort_t* Kp, const ushort_t* Vp, int vstride, int qrow0, int qpos0,
                  int ntiles, int head, bool sample, char* smem, float lam, float M2, float oscale) {
  int t_ = tidx(p); asm volatile("" : "+v"(t_));
  const int t = t_, lane = t & 63, w = t >> 6, l31 = lane & 31, h = lane >> 5;
  const int rg = sample ? (w >> 1) : (w & 3), hc = sample ? (w & 1) : (w >> 2);
  const ushort_t* Qb = (const ushort_t*)(p.ws + WS_Q);
  const ushort_t* GB = (const ushort_t*)(p.ws + WS_GB);
  ushort_t* Y = (ushort_t*)(p.ws + WS_Y);

  int qrow, qpos, mytiles;
  if (sample) { qrow = qrow0 + (l31 & 15); qpos = qpos0 + (l31 & 15); mytiles = (rg == 0) ? ntiles : 0; }
  else { qrow = qrow0 + rg * 32 + l31; qpos = qpos0 + rg * 32 + l31; mytiles = ntiles - 1 + (rg >> 1); }
  const int diagtile = sample ? 16 : (qpos0 >> 6) + (rg >> 1);
  bf16x8 qf[4];
#pragma unroll
  for (int ks = 0; ks < 4; ++ks) qf[ks] = *(const bf16x8*)(Qb + (size_t)qrow * 512 + head * 128 + hc * 64 + ks * 16 + h * 8);
  const float slope2 = exp2f(-2.f * (float)(head + 1)) * LOG2E;

  f32x16 ot[4];
#pragma unroll
  for (int dt = 0; dt < 4; ++dt)
#pragma unroll
    for (int i = 0; i < 16; ++i) ot[dt][i] = 0.f;
  float lsum = 0.f;

  const unsigned lds0 = (unsigned)(size_t)smem;
  unsigned koff[4], voff[4];
#pragma unroll
  for (int x = 0; x < 4; ++x) {
    koff[x] = (unsigned)(l31 * 256 + (((hc * 8 + x * 2 + h) ^ (l31 & 15)) * 16));
    voff[x] = (unsigned)(l31 * 128 + (((x * 2 + h) ^ ((l31 >> 1) & 7)) * 16));
  }
  unsigned ksrc[2], vsrc[2];
#pragma unroll
  for (int i = 0; i < 2; ++i) {
    const int o = t * 16 + i * 8192;
    const int row = o >> 8, cp = (o >> 4) & 15;
    ksrc[i] = (unsigned)(row * 512 + ((cp ^ (row & 15)) * 8)) * 2u;
    const int d = o >> 7, cv = (o >> 4) & 7;
    vsrc[i] = (unsigned)(d * vstride + ((cv ^ ((d >> 1) & 7)) * 8)) * 2u;
  }
  auto issue = [&](int j) {
    char* slot = smem + (j & 3) * 32768;
#pragma unroll
    for (int i = 0; i < 2; ++i) GLDS((const char*)(Kp + (size_t)j * 64 * 512) + ksrc[i], slot + t * 16 + i * 8192);
#pragma unroll
    for (int i = 0; i < 2; ++i) GLDS((const char*)(Vp + (size_t)j * 64) + vsrc[i], slot + 16384 + t * 16 + i * 8192);
  };
#define VREAD(dst, sl, x) do { const unsigned _a = (sl) + voff[x]; \
    DSR(dst[0], _a, 16384); DSR(dst[1], _a, 20480); DSR(dst[2], _a, 24576); DSR(dst[3], _a, 28672); } while (0)
#define VWAIT(n, v) asm volatile("s_waitcnt lgkmcnt(" #n ")" : "+v"(v[0]), "+v"(v[1]), "+v"(v[2]), "+v"(v[3]))
#define PVMMA(v, s2) do { _Pragma("unroll") for (int dt = 0; dt < 4; ++dt) ot[dt] = MFMA32(v[dt], pf[s2], ot[dt]); } while (0)
#define EXP8(kt, o8) do { _Pragma("unroll") for (int i = (o8); i < (o8) + 8; ++i) { \
    const float pv = __builtin_amdgcn_exp2f(st[kt][i]); lsum += pv; st[kt][i] = pv; } } while (0)

  asm volatile("" : "+v"(qf[0]), "+v"(qf[1]), "+v"(qf[2]), "+v"(qf[3]));
  __syncthreads();
  issue(0);
  if (ntiles > 1) issue(1);
  bf16x8 pf[4];
#pragma unroll
  for (int x = 0; x < 4; ++x) pf[x] = (bf16x8){0, 0, 0, 0, 0, 0, 0, 0};
#pragma unroll 1
  for (int j = 0; j <= ntiles; ++j) {
    if (j + 1 < ntiles) { WAIT_V(4); } else { WAIT_V(0); }
    BAR;
    if (j + 2 < ntiles) issue(j + 2);
    const bool doqk = (j < mytiles), dopv = (j >= 1 && j <= mytiles);
    const unsigned slot = lds0 + (unsigned)(j & 3) * 32768u;
    const unsigned pslot = lds0 + (unsigned)((j + 3) & 3) * 32768u;
    f32x16 st[2];
    bf16x8 va[4], vb[4];
    if (dopv) { VREAD(va, pslot, 0); VREAD(vb, pslot, 1); }
    if (doqk) {
      const int dq = qpos - 64 * j - 4 * h;
      bf16x8 ka[4], kb[4];
      {
        const unsigned a0 = slot + koff[0], a1 = slot + koff[1], a2 = slot + koff[2], a3 = slot + koff[3];
        DSR(ka[0], a0, 0); DSR(ka[1], a0, 8192); DSR(ka[2], a1, 0); DSR(ka[3], a1, 8192);
        DSR(kb[0], a2, 0); DSR(kb[1], a2, 8192); DSR(kb[2], a3, 0); DSR(kb[3], a3, 8192);
      }
      if (j < diagtile) {
        const float base = -slope2 * (float)dq - M2;
        float be[4];
#pragma unroll
        for (int e = 0; e < 4; ++e) be[e] = fmaf(slope2, (float)e, base);
#pragma unroll
        for (int kt = 0; kt < 2; ++kt)
#pragma unroll
          for (int g = 0; g < 4; ++g) {
            const float cs = __int_as_float(__builtin_amdgcn_readfirstlane(__float_as_int(slope2 * (float)(32 * kt + 8 * g))));
#pragma unroll
            for (int e = 0; e < 4; ++e) {
              float r;
              asm("v_add_f32 %0, %1, %2" : "=v"(r) : "s"(cs), "v"(be[e]));
              st[kt][4 * g + e] = r;
            }
          }
      } else {
        const bool lastmask = sample && (j == ntiles - 1);
#pragma unroll
        for (int kt = 0; kt < 2; ++kt)
#pragma unroll
          for (int i = 0; i < 16; ++i) {
            const int off = 32 * kt + 8 * (i >> 2) + (i & 3);
            const int dd = dq - off;
            float bv = -slope2 * (float)(dd < 0 ? -dd : dd) - M2;
            if (lastmask && (kt == 1 || (i >> 2) >= 2)) bv = -1e30f;
            st[kt][i] = bv;
          }
      }
      asm volatile("s_waitcnt lgkmcnt(4)" : "+v"(ka[0]), "+v"(ka[1]), "+v"(ka[2]), "+v"(ka[3]));
      st[0] = MFMA32(ka[0], qf[0], st[0]); st[1] = MFMA32(ka[1], qf[0], st[1]);
      st[0] = MFMA32(ka[2], qf[1], st[0]); st[1] = MFMA32(ka[3], qf[1], st[1]);
      asm volatile("s_waitcnt lgkmcnt(0)" : "+v"(kb[0]), "+v"(kb[1]), "+v"(kb[2]), "+v"(kb[3]));
      st[0] = MFMA32(kb[0], qf[2], st[0]); st[1] = MFMA32(kb[1], qf[2], st[1]);
      st[0] = MFMA32(kb[2], qf[3], st[0]); st[1] = MFMA32(kb[3], qf[3], st[1]);
    }
    if (doqk && dopv) {
      VWAIT(0, va); PVMMA(va, 0); EXP8(0, 0);
      VREAD(va, pslot, 2);
      VWAIT(4, vb); PVMMA(vb, 1); EXP8(0, 8);
      VREAD(vb, pslot, 3);
      VWAIT(4, va); PVMMA(va, 2); EXP8(1, 0);
      VWAIT(0, vb); PVMMA(vb, 3); EXP8(1, 8);
    } else if (doqk) {
      EXP8(0, 0); EXP8(0, 8); EXP8(1, 0); EXP8(1, 8);
    } else if (dopv) {
      VWAIT(4, va); PVMMA(va, 0);
      VREAD(va, pslot, 2);
      VWAIT(4, vb); PVMMA(vb, 1);
      VREAD(vb, pslot, 3);
      VWAIT(4, va); PVMMA(va, 2);
      VWAIT(0, vb); PVMMA(vb, 3);
    }
    if (doqk) {
#pragma unroll
      for (int s2 = 0; s2 < 4; ++s2) {
        const int kt = s2 >> 1, o8 = 8 * (s2 & 1);
        union { u32x4 u; bf16x8 v; } cv;
        cv.u.x = pk(st[kt][o8 + 0], st[kt][o8 + 1]);
        cv.u.y = pk(st[kt][o8 + 2], st[kt][o8 + 3]);
        cv.u.z = pk(st[kt][o8 + 4], st[kt][o8 + 5]);
        cv.u.w = pk(st[kt][o8 + 6], st[kt][o8 + 7]);
        pf[s2] = cv.v;
      }
    }
  }
#undef VREAD
#undef VWAIT
#undef PVMMA
#undef EXP8

  lsum += __shfl_xor(lsum, 32);
  const float inv = 1.f / lsum;
  __syncthreads();
  float* Ol = (float*)smem;
  if (hc == 1) {
    const float sc = lam * inv;
#pragma unroll
    for (int dt = 0; dt < 4; ++dt)
#pragma unroll
      for (int g = 0; g < 4; ++g) {
        const int d0 = 32 * dt + 8 * g + 4 * h;
        f32x4 v = {ot[dt][4 * g] * sc, ot[dt][4 * g + 1] * sc, ot[dt][4 * g + 2] * sc, ot[dt][4 * g + 3] * sc};
        *(f32x4*)(Ol + (rg * 32 + l31) * 132 + d0) = v;
      }
  }
  __syncthreads();
  if (hc == 0) {
    float ssq = 0.f;
#pragma unroll
    for (int dt = 0; dt < 4; ++dt)
#pragma unroll
      for (int g = 0; g < 4; ++g) {
        const int d0 = 32 * dt + 8 * g + 4 * h;
        const f32x4 v2 = *(const f32x4*)(Ol + (rg * 32 + l31) * 132 + d0);
        ot[dt][4 * g + 0] = ot[dt][4 * g + 0] * inv - v2.x;
        ot[dt][4 * g + 1] = ot[dt][4 * g + 1] * inv - v2.y;
        ot[dt][4 * g + 2] = ot[dt][4 * g + 2] * inv - v2.z;
        ot[dt][4 * g + 3] = ot[dt][4 * g + 3] * inv - v2.w;
        ssq += ot[dt][4 * g] * ot[dt][4 * g] + ot[dt][4 * g + 1] * ot[dt][4 * g + 1] + ot[dt][4 * g + 2] * ot[dt][4 * g + 2] +
               ot[dt][4 * g + 3] * ot[dt][4 * g + 3];
      }
    ssq += __shfl_xor(ssq, 32);
    const float rn = rsqrtf(ssq * (1.f / 128.f) + EPS) * oscale;
    const bool valid = sample ? (rg == 0 && l31 < 16) : true;
    const float* sg = p.subln_g + l * 128;
    ushort_t* yrow = Y + (size_t)qrow * 1024 + 512 + head * 128;
    const ushort_t* gbrow = GB + (size_t)qrow * 512 + head * 128;
#pragma unroll
    for (int dt = 0; dt < 4; ++dt)
#pragma unroll
      for (int gp = 0; gp < 2; ++gp) {
        u32x2 og[2];
#pragma unroll
        for (int q = 0; q < 2; ++q) {
          const int g = 2 * gp + q;
          const int d0 = 32 * dt + 8 * g + 4 * h;
          const u32x2 gb = *(const u32x2*)(gbrow + d0);
          const f32x4 gg = *(const f32x4*)(sg + d0);
          og[q].x = pk(ot[dt][4 * g] * rn * gg.x * bflo(gb.x), ot[dt][4 * g + 1] * rn * gg.y * bfhi(gb.x));
          og[q].y = pk(ot[dt][4 * g + 2] * rn * gg.z * bflo(gb.y), ot[dt][4 * g + 3] * rn * gg.w * bfhi(gb.y));
        }
        const u32x2 snd = h ? og[0] : og[1];
        u32x2 rcv;
        rcv.x = (unsigned)__shfl_xor((int)snd.x, 32);
        rcv.y = (unsigned)__shfl_xor((int)snd.y, 32);
        u32x4 o16;
        if (h == 0) { o16.x = og[0].x; o16.y = og[0].y; o16.z = rcv.x; o16.w = rcv.y; }
        else { o16.x = rcv.x; o16.y = rcv.y; o16.z = og[1].x; o16.w = og[1].y; }
        if (valid) *(u32x4*)(yrow + 32 * dt + 16 * gp + 8 * h) = o16;
      }
  }
}

DI void sgu_unit(const Params& p, int l, int b, int n, int head, char* smem) {
  int t_ = tidx(p); asm volatile("" : "+v"(t_));
  const int t = t_, lane = t & 63, w = t >> 6, l31 = lane & 31, h = lane >> 5;
  const int dtile = w & 3, th = w >> 2;
  const ushort_t* UG = (const ushort_t*)(p.ws + WS_UG);
  const ushort_t* VNT = (const ushort_t*)(p.ws + WS_VNT);
  ushort_t* Y = (ushort_t*)(p.ws + WS_Y);
  char* Wl = smem;
  const float* W = p.sgu_w + (size_t)(l * 4 + head) * 128 * 128;
  __syncthreads();
#pragma unroll
  for (int i = 0; i < 4; ++i) {
    const int f = t + 512 * i, row = f >> 4, c8 = f & 15;
    f32x4 a = *(const f32x4*)(W + row * 128 + c8 * 8);
    f32x4 bq = *(const f32x4*)(W + row * 128 + c8 * 8 + 4);
    const int s0 = c8 * 8;
    if (s0 + 0 > row) a.x = 0.f; if (s0 + 1 > row) a.y = 0.f; if (s0 + 2 > row) a.z = 0.f; if (s0 + 3 > row) a.w = 0.f;
    if (s0 + 4 > row) bq.x = 0.f; if (s0 + 5 > row) bq.y = 0.f; if (s0 + 6 > row) bq.z = 0.f; if (s0 + 7 > row) bq.w = 0.f;
    *(u32x4*)(Wl + row * 272 + c8 * 16) = pk8(a, bq);
  }
  bf16x8 af[8];
#pragma unroll
  for (int ks = 0; ks < 8; ++ks)
    af[ks] = *(const bf16x8*)(VNT + ((size_t)(b * 4 + head) * 128 + 32 * dtile + l31) * 2048 + n * 128 + ks * 16 + h * 8);
  __syncthreads();
  f32x16 acc[2];
#pragma unroll
  for (int q = 0; q < 2; ++q) {
#pragma unroll
    for (int i = 0; i < 16; ++i) acc[q][i] = 0.f;
#pragma unroll
    for (int ks = 0; ks < 8; ++ks) {
      if (ks <= 4 * th + 2 * q + 1) {
        const bf16x8 bw = *(const bf16x8*)(Wl + (32 * (2 * th + q) + l31) * 272 + ks * 32 + h * 16);
        acc[q] = MFMA32(af[ks], bw, acc[q]);
      }
    }
  }
#pragma unroll
  for (int q = 0; q < 2; ++q) {
    const int tt = 32 * (2 * th + q) + l31;
    const size_t r = (size_t)b * 2048 + n * 128 + tt;
    const float bias = p.sgu_b[(l * 4 + head) * 128 + tt];
#pragma unroll
    for (int g = 0; g < 4; ++g) {
      const int d0 = 32 * dtile + 8 * g + 4 * h;
      const u32x2 u = *(const u32x2*)(UG + r * 512 + head * 128 + d0);
      u32x2 o;
      o.x = pk((acc[q][4 * g] + bias) * bflo(u.x), (acc[q][4 * g + 1] + bias) * bfhi(u.x));
      o.y = pk((acc[q][4 * g + 2] + bias) * bflo(u.y), (acc[q][4 * g + 3] + bias) * bfhi(u.y));
      *(u32x2*)(Y + r * 1024 + head * 128 + d0) = o;
    }
  }
}

DI void sgu_sample_unit(const Params& p, int l, int b, int head) {
  const int t = tidx(p);
  const ushort_t* UG = (const ushort_t*)(p.ws + WS_UG);
  const ushort_t* VNS = (const ushort_t*)(p.ws + WS_VNS);
  ushort_t* Y = (ushort_t*)(p.ws + WS_Y);
  const float* W = p.sgu_w + (size_t)(l * 4 + head) * 128 * 128;
  for (int idx = t; idx < 2048; idx += 512) {
    const int tt = idx >> 7, d = idx & 127, col = head * 128 + d;
    float wv[16], vv[16];
#pragma unroll
    for (int q = 0; q < 16; ++q) {
      wv[q] = W[tt * 128 + q];
      vv[q] = bflo((unsigned)VNS[(size_t)(b * 16 + q) * 512 + col]);
    }
    float a = p.sgu_b[(l * 4 + head) * 128 + tt];
#pragma unroll
    for (int q = 0; q < 16; ++q) a += (q <= tt) ? wv[q] * vv[q] : 0.f;
    const size_t r = (size_t)TP + b * 16 + tt;
    const float y = a * bflo((unsigned)UG[r * 512 + col]);
    Y[r * 1024 + col] = (ushort_t)(pk(y, y) & 0xffff);
  }
}

DI void phase_mix(const Params& p, int l, char* smem, int* s_item) {
  const float* par = (const float*)(p.ws + WS_PAR);
  const float lam = par[l * 4 + 0], M2 = par[l * 4 + 1], oscale = par[l * 4 + 2];
  const int G = gridDim.x;
  const ushort_t* Kb = (const ushort_t*)(p.ws + WS_K);
  const ushort_t* VT = (const ushort_t*)(p.ws + WS_VT);
  const ushort_t* KSB = (const ushort_t*)(p.ws + WS_KSB);
  const ushort_t* VTS = (const ushort_t*)(p.ws + WS_VTS);
  for (int u0 = blockIdx.x; u0 < 256; u0 += G) {
    const int u = ((G & 7) == 0 && G >= 256) ? ((u0 & 7) * 32 + (u0 >> 3)) : u0;
    const int bh = u >> 3, pi = u & 7, b = bh >> 2, head = bh & 3;
#pragma unroll 1
    for (int half = 0; half < 2; ++half) {
      const int qb = half ? pi : 15 - pi;
      attn_unit(p, l, Kb + (size_t)b * 2048 * 512 + head * 128, VT + (size_t)(b * 4 + head) * 128 * 2048, 2048,
                b * 2048 + qb * 128, qb * 128, 2 * qb + 2, head, false, smem, lam, M2, oscale);
    }
  }
  for (int u = blockIdx.x; u < 64; u += G) {
    const int b = u >> 2, head = u & 3;
    attn_unit(p, l, KSB + (size_t)(l * 16 + b) * SROWS * 512 + head * 128, VTS + (size_t)((l * 16 + b) * 4 + head) * 128 * SROWS,
              SROWS, TP + b * 16, 1024, 17, head, true, smem, lam, M2, oscale);
  }
  unsigned* ctr = (unsigned*)(p.ws + WS_PAR) + 16 + l;
  while (true) {
    __syncthreads();
    if (tidx(p) == 0) *s_item = (int)atomicAdd(ctr, 1u);
    __syncthreads();
    const int item = *s_item;
    if (item >= 576) break;
    if (item < 64) sgu_sample_unit(p, l, item >> 2, item & 3);
    else { const int j = item - 64; sgu_unit(p, l, j >> 6, (j >> 2) & 15, j & 3, smem); }
  }
}

DI void phase_out(const Params& p, int l, char* smem) {
  const ushort_t* Y = (const ushort_t*)(p.ws + WS_Y);
  const ushort_t* Wt = (const ushort_t*)(p.ws + WS_WOUT) + (size_t)l * DM * DM;
  ushort_t* XB = (ushort_t*)(p.ws + WS_XB);
  float* ssq1 = (float*)(p.ws + WS_SSQ) + TT;
  const int G = gridDim.x;
  constexpr int NTILES = 64 * 4;
  for (int id = blockIdx.x; id < NTILES; id += G) {
    const int mt = id >> 2, ntile = id & 3;
    f32x4 acc[2][2][4][2];
    gemm256(Wt + (size_t)ntile * 256 * 1024, Y + (size_t)mt * 256 * 1024, acc, smem, tidx(p));
    int t_ = tidx(p); asm volatile("" : "+v"(t_));
    const int tid = t_, wid = tid >> 6, lane = tid & 63, wr = wid >> 2, wc = wid & 3, fr = lane & 15, fq = lane >> 4;
#pragma unroll
    for (int bj = 0; bj < 2; ++bj)
#pragma unroll
      for (int n = 0; n < 2; ++n) {
        const int tk = mt * 256 + bj * 128 + wc * 32 + n * 16 + fr;
        float* orow = p.out + (size_t)tk * 1024;
        float s = 0.f;
#pragma unroll
        for (int ai = 0; ai < 2; ++ai)
#pragma unroll
          for (int m = 0; m < 4; ++m) {
            const int c0 = ntile * 256 + ai * 128 + wr * 64 + m * 16 + fq * 4;
            const u32x2 xb = *(const u32x2*)(XB + (size_t)tk * 1024 + c0);
            f32x4 xv = {bflo(xb.x), bfhi(xb.x), bflo(xb.y), bfhi(xb.y)};
            xv += acc[ai][bj][m][n];
            if (l == 1) __builtin_nontemporal_store(xv, (f32x4*)(orow + c0));
            if (l == 0) {
              s += xv.x * xv.x + xv.y * xv.y + xv.z * xv.z + xv.w * xv.w;
              u32x2 o; o.x = pk(xv.x, xv.y); o.y = pk(xv.z, xv.w);
              *(u32x2*)(XB + (size_t)tk * 1024 + c0) = o;
            }
          }
        if (l == 0) {
          s += __shfl_xor(s, 16); s += __shfl_xor(s, 32);
          if (fq == 0) atomicAdd(ssq1 + tk, s);
        }
      }
  }
  for (int it = blockIdx.x; it < 256; it += G) {
    const int tid = tidx(p), wid = tid >> 6, lane = tid & 63, fr = lane & 15, fq = lane >> 4;
    const int sl = it >> 2, tg = it & 3, tt = wid & 3, kh = wid >> 2;
    const int tk = TP + tg * 64 + tt * 16 + fr;
    const ushort_t* wp = Wt + (size_t)(sl * 16 + fr) * 1024 + kh * 512 + fq * 8;
    const ushort_t* yp = Y + (size_t)tk * 1024 + kh * 512 + fq * 8;
    bf16x8 wf[16], yf[16];
#pragma unroll
    for (int q = 0; q < 16; ++q) { wf[q] = *(const bf16x8*)(wp + q * 32); yf[q] = *(const bf16x8*)(yp + q * 32); }
    f32x4 a0 = {0.f, 0.f, 0.f, 0.f};
#pragma unroll
    for (int q = 0; q < 16; ++q) a0 = MFMA16(wf[q], yf[q], a0);
    float* cx = (float*)smem;
    __syncthreads();
    if (kh == 1) *(f32x4*)(cx + (tt * 64 + lane) * 4) = a0;
    __syncthreads();
    if (kh == 0) {
      a0 += *(const f32x4*)(cx + (tt * 64 + lane) * 4);
      const int c0 = sl * 16 + fq * 4;
      const u32x2 xb = *(const u32x2*)(XB + (size_t)tk * 1024 + c0);
      f32x4 xv = {bflo(xb.x), bfhi(xb.x), bflo(xb.y), bfhi(xb.y)};
      xv += a0;
      if (l == 1) *(f32x4*)(p.out + (size_t)tk * 1024 + c0) = xv;
      if (l == 0) {
        float sq = xv.x * xv.x + xv.y * xv.y + xv.z * xv.z + xv.w * xv.w;
        u32x2 o; o.x = pk(xv.x, xv.y); o.y = pk(xv.z, xv.w);
        *(u32x2*)(XB + (size_t)tk * 1024 + c0) = o;
        sq += __shfl_xor(sq, 16); sq += __shfl_xor(sq, 32);
        if (fq == 0) atomicAdd(ssq1 + tk, sq);
      }
    }
  }
}

DI unsigned bar_ld(unsigned* p) { return __hip_atomic_load(p, __ATOMIC_RELAXED, __HIP_MEMORY_SCOPE_AGENT); }
DI unsigned bar_add(unsigned* p, unsigned v) { return __hip_atomic_fetch_add(p, v, __ATOMIC_RELAXED, __HIP_MEMORY_SCOPE_AGENT); }
DI unsigned xcc_id() { return (unsigned)__builtin_amdgcn_s_getreg((3 << 11) | 20) & 0xFu; }

DI void grid_barrier(unsigned* ctr, unsigned target, bool leader) {
  asm volatile("s_waitcnt vmcnt(0)" ::: "memory");
  __syncthreads();
  if (leader) {
    __builtin_amdgcn_fence(__ATOMIC_RELEASE, "agent");
    asm volatile("s_waitcnt vmcnt(0)" ::: "memory");
    bar_add(ctr, 1u);
    while (bar_ld(ctr) < target) __builtin_amdgcn_s_sleep(1);
    __builtin_amdgcn_fence(__ATOMIC_ACQUIRE, "agent");
    asm volatile("s_waitcnt vmcnt(0)" ::: "memory");
  }
  __syncthreads();
}
DI void xcd_barrier(unsigned* bar, unsigned round, const unsigned* s_nxcc, bool leader) {
  asm volatile("s_waitcnt vmcnt(0)" ::: "memory");
  __syncthreads();
  if (leader) {
    const unsigned xcc = xcc_id(), nxcc = *s_nxcc;
    const unsigned mine = bar_ld(bar + 64 + 64 * xcc);
    const unsigned old = bar_add(bar + 1088 + 64 * xcc, 1u);
    if (old + 1u == round * mine) {
      __builtin_amdgcn_fence(__ATOMIC_RELEASE, "agent");
      asm volatile("s_waitcnt vmcnt(0)" ::: "memory");
      bar_add(bar + 2112, 1u);
    }
    while (bar_ld(bar + 2112) < round * nxcc) __builtin_amdgcn_s_sleep(1);
    __builtin_amdgcn_fence(__ATOMIC_ACQUIRE, "agent");
    asm volatile("s_waitcnt vmcnt(0)" ::: "memory");
  }
  __syncthreads();
}

__global__ void __launch_bounds__(512, 1) mega_kernel(Params p0) {
  PW p;
  static_cast<Params&>(p) = p0;
  p.wv = __builtin_amdgcn_readfirstlane((int)(threadIdx.x >> 6));
  const bool leader = (tidx(p) == 0);
  __shared__ __attribute__((aligned(16))) char smem[SMEM_BYTES];
  __shared__ int s_item;
  __shared__ unsigned s_nxcc;
  cg::grid_group grid = cg::this_grid();
  if (p0.ws == nullptr) grid.sync();
  unsigned* bar = (unsigned*)(p.ws + WS_BAR);
  const unsigned G = gridDim.x;
  if (leader) bar_add(bar + 64 + 64 * xcc_id(), 1u);
  phase_prep(p, smem);
  if (leader) {
    unsigned n, tot;
    do {
      n = 0; tot = 0;
      for (int x = 0; x < 16; ++x) { const unsigned c = bar_ld(bar + 64 + 64 * x); tot += c; n += (c != 0u) ? 1u : 0u; }
      if (tot < G) __builtin_amdgcn_s_sleep(1);
    } while (tot < G);
    s_nxcc = n;
  }
  xcd_barrier(bar, 1, &s_nxcc, leader);
#pragma unroll 1
  for (int l = 0; l < 2; ++l) {
    phase_in(p, l, smem);
    xcd_barrier(bar, 3 * l + 2, &s_nxcc, leader);
    phase_mix(p, l, smem, &s_item);
    xcd_barrier(bar, 3 * l + 3, &s_nxcc, leader);
    phase_out(p, l, smem);
    if (l == 0) xcd_barrier(bar, 4, &s_nxcc, leader);
  }
}

extern "C" void kernel_launch(void* const* d_in, const int* in_sizes, int n_in, void* d_out, int out_size, void* d_ws,
                              size_t ws_size, hipStream_t stream) {
  static int grid_blocks = 0;
  if (!grid_blocks) {
    int dev = 0, cus = 0, per_cu = 0;
    (void)hipGetDevice(&dev);
    (void)hipDeviceGetAttribute(&cus, hipDeviceAttributeMultiprocessorCount, dev);
    (void)hipOccupancyMaxActiveBlocksPerMultiprocessor(&per_cu, mega_kernel, 512, 0);
    if (per_cu > 1) per_cu = 1;
    if (per_cu < 1) per_cu = 1;
    grid_blocks = cus * per_cu;
  }
  Params p{};
  p.x_prompt = (const float*)d_in[0]; p.x_sample = (const float*)d_in[1];
  p.cache_k = (const float*)d_in[2]; p.cache_v = (const float*)d_in[3];
  p.norm_g = (const float*)d_in[4]; p.w_in = (const float*)d_in[5];
  p.sgu_norm_g = (const float*)d_in[6]; p.sgu_w = (const float*)d_in[7]; p.sgu_b = (const float*)d_in[8];
  p.q_norm_g = (const float*)d_in[9]; p.k_norm_g = (const float*)d_in[10];
  p.lq1 = (const float*)d_in[11]; p.lk1 = (const float*)d_in[12]; p.lq2 = (const float*)d_in[13]; p.lk2 = (const float*)d_in[14];
  p.subln_g = (const float*)d_in[15]; p.w_out = (const float*)d_in[16];
  p.out = (float*)d_out; p.ws = (char*)d_ws;
  (void)hipMemsetAsync((char*)d_ws + WS_BAR, 0, 16384, stream);
  void* args[] = {&p};
  hipError_t e = hipLaunchCooperativeKernel((void*)mega_kernel, dim3(grid_blocks), dim3(512), args, 0, stream);
  if (e != hipSuccess) fprintf(stderr, "cooperative launch failed: %s (grid %d)\n", hipGetErrorString(e), grid_blocks);
}
```

```cpp
#include <hip/hip_runtime.h>
#include <hip/hip_cooperative_groups.h>
#include <cstdio>
namespace cg = cooperative_groups;

typedef __attribute__((ext_vector_type(8))) short bf16x8;
typedef __attribute__((ext_vector_type(16))) float f32x16;
typedef __attribute__((ext_vector_type(4))) float f32x4;
typedef __bf16 bf16x2_t __attribute__((ext_vector_type(2)));
typedef float f32x2_t __attribute__((ext_vector_type(2)));
typedef unsigned short ushort_t;
typedef unsigned u32x4 __attribute__((ext_vector_type(4)));
typedef unsigned u32x2 __attribute__((ext_vector_type(2)));

#define DI __device__ __forceinline__
#define MFMA32(a, b, c) __builtin_amdgcn_mfma_f32_32x32x16_bf16((a), (b), (c), 0, 0, 0)
#define MFMA16(a, b, c) __builtin_amdgcn_mfma_f32_16x16x32_bf16((a), (b), (c), 0, 0, 0)
#define GLDS(gp, lp) __builtin_amdgcn_global_load_lds((const unsigned*)(gp), (unsigned*)(lp), 16, 0, 0)
#define GLDS_NT(gp, lp) __builtin_amdgcn_global_load_lds((const unsigned*)(gp), (unsigned*)(lp), 16, 0, 2)
#define WAIT_V(n) asm volatile("s_waitcnt vmcnt(" #n ")" ::: "memory")
#define WAIT_L(n) asm volatile("s_waitcnt lgkmcnt(" #n ")" ::: "memory")
#define BAR __builtin_amdgcn_s_barrier()
#define SCHED __builtin_amdgcn_sched_barrier(0)
#define LDS_BARRIER() do { asm volatile("s_waitcnt lgkmcnt(0)" ::: "memory"); __builtin_amdgcn_s_barrier(); asm volatile("" ::: "memory"); } while (0)
#define DSR(dst, addr, imm) asm volatile("ds_read_b128 %0, %1 offset:%2" : "=v"(dst) : "v"(addr), "n"(imm))

constexpr int DM = 1024, NIN = 3584, TP = 16384, TT = 16640;
constexpr int SROWS = 1088;
constexpr float EPS = 1e-6f;
constexpr float LOG2E = 1.4426950408889634f;

constexpr size_t OKP = 17039360, OVP = 33816576, OKS = 50593792, OVS = 50855936, OSGU = 51118080;

constexpr size_t SZ_ACT = (size_t)TT * 512 * 2;
constexpr size_t WS_WIN = 0;
constexpr size_t WS_WOUT = WS_WIN + (size_t)2 * NIN * DM * 2;
constexpr size_t WS_XB = WS_WOUT + (size_t)2 * DM * DM * 2;
constexpr size_t WS_UG = WS_XB + (size_t)TT * 1024 * 2;
constexpr size_t WS_Q = WS_UG + SZ_ACT;
constexpr size_t WS_K = WS_Q + SZ_ACT;
constexpr size_t WS_GB = WS_K + SZ_ACT;
constexpr size_t WS_VNT = WS_GB + SZ_ACT;
constexpr size_t WS_VNS = WS_VNT + (size_t)32 * 128 * 2048 * 2;
constexpr size_t WS_VT = WS_VNS + (size_t)256 * 512 * 2;
constexpr size_t WS_Y = WS_VT + (size_t)32 * 128 * 2048 * 2;
constexpr size_t WS_KSB = WS_Y + (size_t)TT * 1024 * 2;
constexpr size_t WS_VTS = WS_KSB + (size_t)2 * 16 * SROWS * 512 * 2;
constexpr size_t WS_SSQ = WS_VTS + (size_t)2 * 16 * 4 * 128 * SROWS * 2;
constexpr size_t WS_PAR = WS_SSQ + (size_t)2 * TT * 4;
constexpr size_t WS_BAR = WS_PAR + 256;
constexpr size_t WS_END = WS_BAR + 16384;
static_assert(WS_END <= (size_t)256 * 1024 * 1024, "workspace too large");

constexpr int EX_OFF = 131072;
constexpr int RS_OFF = 131072 + 4096;
constexpr int SMEM_BYTES = 131072 + 4096 + 1024 + 64;

struct Params {
  const float* x_prompt; const float* x_sample; const float* cache_k; const float* cache_v;
  const float* norm_g; const float* w_in; const float* sgu_norm_g; const float* sgu_w; const float* sgu_b;
  const float* q_norm_g; const float* k_norm_g; const float* lq1; const float* lk1; const float* lq2; const float* lk2;
  const float* subln_g; const float* w_out;
  float* out; char* ws;
};
struct PW : Params { int wv; };
__device__ __forceinline__ int tidx(const Params& p) {
  int lane;
  asm volatile("v_mbcnt_lo_u32_b32 %0, -1, 0\n\tv_mbcnt_hi_u32_b32 %0, -1, %0" : "=v"(lane));
  return static_cast<const PW&>(p).wv * 64 + lane;
}

DI unsigned pk(float a, float b) {
  f32x2_t v = {a, b};
  bf16x2_t r = __builtin_convertvector(v, bf16x2_t);
  return __builtin_bit_cast(unsigned, r);
}
DI float bflo(unsigned u) { return __uint_as_float(u << 16); }
DI float bfhi(unsigned u) { return __uint_as_float(u & 0xffff0000u); }
DI float silu(float v) { return v * __builtin_amdgcn_rcpf(1.f + __expf(-v)); }
DI u32x4 pk8(f32x4 a, f32x4 b) {
  u32x4 r; r.x = pk(a.x, a.y); r.y = pk(a.z, a.w); r.z = pk(b.x, b.y); r.w = pk(b.z, b.w); return r;
}
DI int kperm(int k16) { return 8 * ((k16 >> 2) & 1) + (k16 & 3) + 4 * (k16 >> 3); }
DI int kinv(int p16) { return 8 * ((p16 & 7) >> 2) + 4 * (p16 >> 3) + (p16 & 3); }

struct TTRegs { f32x4 v[2]; float g[2]; };
DI void tt_load(TTRegs& R, const float* src, size_t sstride, const float* g, int t) {
#pragma unroll
  for (int i = 0; i < 2; ++i) {
    const int f = t + 512 * i, r = f >> 4, c4 = f & 15;
    R.v[i] = __builtin_nontemporal_load((const f32x4*)(src + (size_t)r * sstride + c4 * 4));
    R.g[i] = g ? g[r] : 1.f;
  }
}
DI void tt_to_lds(const TTRegs& R, float* tile, int t) {
#pragma unroll
  for (int i = 0; i < 2; ++i) {
    const int f = t + 512 * i, r = f >> 4, c4 = f & 15;
    float* tp = tile + r * 65 + c4 * 4;
    tp[0] = R.v[i].x * R.g[i]; tp[1] = R.v[i].y * R.g[i]; tp[2] = R.v[i].z * R.g[i]; tp[3] = R.v[i].w * R.g[i];
  }
}
DI void tt_store(ushort_t* dst, size_t dstride, bool perm, const float* tile, int t) {
  const int c = t >> 3, k8 = t & 7;
  float v[8];
#pragma unroll
  for (int e = 0; e < 8; ++e) {
    const int p = k8 * 8 + e;
    const int r = perm ? ((p & ~15) + kinv(p & 15)) : p;
    v[e] = tile[r * 65 + c];
  }
  u32x4 o; o.x = pk(v[0], v[1]); o.y = pk(v[2], v[3]); o.z = pk(v[4], v[5]); o.w = pk(v[6], v[7]);
  if (perm) __builtin_nontemporal_store(o, (u32x4*)(dst + (size_t)c * dstride + k8 * 8));
  else *(u32x4*)(dst + (size_t)c * dstride + k8 * 8) = o;
}

DI int src_section(int sec) {
  const int nt = sec >> 1, ai = sec & 1;
  if (nt < 4) return ai ? 8 + nt : nt;
  if (nt < 6) return 4 + 2 * (nt - 4) + ai;
  if (nt < 10) return ai ? 16 + (nt - 6) : 12 + (nt - 6);
  return ai ? 24 + (nt - 10) : 20 + (nt - 10);
}

DI void phase_prep(const Params& p, char* smem) {
  float* tile = (float*)smem;
  int t_ = tidx(p); asm volatile("" : "+v"(t_));
  const int t = t_, lane = t & 63, w = t >> 6;
  const int G = gridDim.x;
  {
    struct TJob { const float* src; size_t ss; ushort_t* dst; size_t ds; const float* g; bool perm; };
    auto job = [&](int item) {
      TJob J;
      if (item < 2304) {
        const int l = item / 1152;
        int idx = item % 1152;
        if (idx < 896) {
          const int kt = idx / 56, db = idx % 56;
          const int sb = src_section(db >> 1) * 2 + (db & 1);
          J.src = p.w_in + (size_t)l * DM * NIN + (size_t)(kt * 64) * NIN + sb * 64; J.ss = NIN;
          J.dst = (ushort_t*)(p.ws + WS_WIN) + (size_t)l * NIN * DM + (size_t)(db * 64) * DM + kt * 64; J.ds = DM;
          J.g = p.norm_g + l * DM + kt * 64; J.perm = false;
        } else {
          idx -= 896;
          const int kt = idx / 16, nb = idx % 16;
          J.src = p.w_out + (size_t)l * DM * DM + (size_t)(kt * 64) * DM + nb * 64; J.ss = DM;
          J.dst = (ushort_t*)(p.ws + WS_WOUT) + (size_t)l * DM * DM + (size_t)(nb * 64) * DM + kt * 64; J.ds = DM;
          J.g = nullptr; J.perm = false;
        }
      } else {
        const int it = item - 2304;
        const int dh = it & 1, head = (it >> 1) & 3, pt = (it >> 3) & 15, lb = it >> 7;
        J.src = p.cache_v + ((size_t)lb * 1024 + pt * 64) * 512 + head * 128 + dh * 64; J.ss = 512;
        J.dst = (ushort_t*)(p.ws + WS_VTS) + ((size_t)(lb * 4 + head) * 128 + dh * 64) * SROWS + pt * 64; J.ds = SROWS;
        J.g = nullptr; J.perm = true;
      }
      return J;
    };
    constexpr int NJ = 2304 + 4096;
    TTRegs R[4];
    TJob J[4];
    int item = blockIdx.x * 4;
    if (item < NJ) {
#pragma unroll
      for (int u = 0; u < 4; ++u) { J[u] = job(item + u); tt_load(R[u], J[u].src, J[u].ss, J[u].g, t); }
    }
    while (item < NJ) {
      __syncthreads();
#pragma unroll
      for (int u = 0; u < 4; ++u) tt_to_lds(R[u], tile + u * 4160, t);
      __syncthreads();
      TJob Jc[4];
#pragma unroll
      for (int u = 0; u < 4; ++u) Jc[u] = J[u];
      const int nxt = item + G * 4;
      if (nxt < NJ) {
#pragma unroll
        for (int u = 0; u < 4; ++u) { J[u] = job(nxt + u); tt_load(R[u], J[u].src, J[u].ss, J[u].g, t); }
      }
#pragma unroll
      for (int u = 0; u < 4; ++u) tt_store(Jc[u].dst, Jc[u].ds, Jc[u].perm, tile + u * 4160, t);
      item = nxt;
    }
  }
  {
    ushort_t* XB = (ushort_t*)(p.ws + WS_XB);
    float* ssq = (float*)(p.ws + WS_SSQ);
    for (int row0 = (blockIdx.x * 8 + w) * 4; row0 < TT; row0 += G * 32) {
      f32x4 v[4][4];
#pragma unroll
      for (int rr = 0; rr < 4; ++rr) {
        const int row = row0 + rr;
        const float* xr = (row < TP) ? p.x_prompt + (size_t)row * 1024 : p.x_sample + (size_t)(row - TP) * 1024;
#pragma unroll
        for (int i = 0; i < 4; ++i) v[rr][i] = __builtin_nontemporal_load((const f32x4*)(xr + i * 256 + lane * 4));
      }
#pragma unroll
      for (int rr = 0; rr < 4; ++rr) {
        const int row = row0 + rr;
        float sq = 0.f;
#pragma unroll
        for (int i = 0; i < 4; ++i) {
          const f32x4 a = v[rr][i];
          sq += a.x * a.x + a.y * a.y + a.z * a.z + a.w * a.w;
          u32x2 o; o.x = pk(a.x, a.y); o.y = pk(a.z, a.w);
          *(u32x2*)(XB + (size_t)row * 1024 + i * 256 + lane * 4) = o;
        }
#pragma unroll
        for (int m = 1; m < 64; m <<= 1) sq += __shfl_xor(sq, m);
        if (lane == 0) { ssq[row] = sq; ssq[TT + row] = 0.f; }
      }
    }
  }
  {
    ushort_t* KSB = (ushort_t*)(p.ws + WS_KSB);
    for (int row0 = (blockIdx.x * 8 + w) * 4; row0 < 32768; row0 += G * 32) {
      f32x4 a[4], b4[4];
#pragma unroll
      for (int rr = 0; rr < 4; ++rr) {
        const float* sr = p.cache_k + (size_t)(row0 + rr) * 512 + lane * 8;
        a[rr] = __builtin_nontemporal_load((const f32x4*)sr); b4[rr] = __builtin_nontemporal_load((const f32x4*)(sr + 4));
      }
#pragma unroll
      for (int rr = 0; rr < 4; ++rr) {
        const int row = row0 + rr, lb = row >> 10, pos = row & 1023;
        __builtin_nontemporal_store(pk8(a[rr], b4[rr]), (u32x4*)(KSB + ((size_t)lb * SROWS + pos) * 512 + lane * 8));
      }
    }
  }
  if (blockIdx.x == 0 && w == 0) {
#pragma unroll
    for (int l = 0; l < 2; ++l) {
      float s1 = p.lq1[l * 64 + lane] * p.lk1[l * 64 + lane];
      float s2 = p.lq2[l * 64 + lane] * p.lk2[l * 64 + lane];
      float mq = fabsf(p.q_norm_g[l * 64 + lane]);
      float mk = fabsf(p.k_norm_g[l * 64 + lane]);
#pragma unroll
      for (int m = 1; m < 64; m <<= 1) {
        s1 += __shfl_xor(s1, m); s2 += __shfl_xor(s2, m);
        mq = fmaxf(mq, __shfl_xor(mq, m)); mk = fmaxf(mk, __shfl_xor(mk, m));
      }
      if (lane == 0) {
        const float lam_init = 0.8f - 0.6f * expf(-0.3f * (float)l);
        float* par = (float*)(p.ws + WS_PAR);
        par[l * 4 + 0] = expf(s1) - expf(s2) + lam_init;
        par[l * 4 + 1] = 8.f * mq * mk * 1.03f * LOG2E + 0.25f;
        par[l * 4 + 2] = 1.f - lam_init;
        atomicExch((unsigned*)(p.ws + WS_PAR) + 16 + l, 0u);
      }
    }
  }
}

DI int lds_byte(int r, int c) {
  const int st = (r >> 4) * 2 + (c >> 5), rr = r & 15, cc = c & 31, ob = rr * 64 + cc * 2;
  return st * 1024 + (ob ^ (((ob >> 9) & 1) << 5));
}
DI void stage_rc(int b, int& R, int& C) {
  const int st = b / 1024, sb = b % 1024, swz = sb ^ (((sb >> 9) & 1) << 5);
  R = (st >> 1) * 16 + swz / 64; C = (st & 1) * 32 + (swz % 64) / 2;
}

DI void gemm256(const ushort_t* A, const ushort_t* Bt, f32x4 (&acc)[2][2][4][2], char* shmc, int tid_in) {
  constexpr int K = 1024, BK = 64, HALF = 128, HT = HALF * BK;
  ushort_t* shm = (ushort_t*)shmc;
#define SA(b, h) (shm + ((b) * 2 + (h)) * HT)
#define SB(b, h) (shm + (4 + (b) * 2 + (h)) * HT)
#define STAGE(P, BASE, br, kt) do { const long _g = (long)(br) * K + (long)(kt) * BK; \
    _Pragma("unroll") for (int _i = 0; _i < 2; ++_i) { const int _b = tid * 16 + _i * 8192; int _r, _c; stage_rc(_b, _r, _c); \
      GLDS(BASE + _g + (long)_r * K + _c, (char*)(P) + _b); } } while (0)
#define LDA(dst, b, h) do { const unsigned _a = a_base + ((b) * 2 + (h)) * 16384u; \
    DSR(dst[0][0], _a, 0); DSR(dst[0][1], _a, 1024); DSR(dst[1][0], _a, 2048); DSR(dst[1][1], _a, 3072); \
    DSR(dst[2][0], _a, 4096); DSR(dst[2][1], _a, 5120); DSR(dst[3][0], _a, 6144); DSR(dst[3][1], _a, 7168); } while (0)
#define LDB(dst, b, h) do { const unsigned _a = b_base + (4 + (b) * 2 + (h)) * 16384u; \
    DSR(dst[0][0], _a, 0); DSR(dst[0][1], _a, 1024); DSR(dst[1][0], _a, 2048); DSR(dst[1][1], _a, 3072); } while (0)
#define TIE(Bx) asm volatile("s_waitcnt lgkmcnt(0)" : "+v"(At[0][0]), "+v"(At[0][1]), "+v"(At[1][0]), "+v"(At[1][1]), \
    "+v"(At[2][0]), "+v"(At[2][1]), "+v"(At[3][0]), "+v"(At[3][1]), "+v"(Bx[0][0]), "+v"(Bx[0][1]), "+v"(Bx[1][0]), "+v"(Bx[1][1]))
#define MMA(ai, bj, At_, Bt_) do { __builtin_amdgcn_s_setprio(1); \
    _Pragma("unroll") for (int m = 0; m < 4; ++m) _Pragma("unroll") for (int n = 0; n < 2; ++n) _Pragma("unroll") for (int k = 0; k < 2; ++k) \
      acc[ai][bj][m][n] = MFMA16(At_[m][k], Bt_[n][k], acc[ai][bj][m][n]); \
    __builtin_amdgcn_s_setprio(0); } while (0)

  int tid_ = tid_in; asm volatile("" : "+v"(tid_));
  const int tid = tid_;
  const int wid = tid >> 6, lane = tid & 63, wr = wid >> 2, wc = wid & 3, fr = lane & 15, fq = lane >> 4;
  const unsigned lds0 = (unsigned)(size_t)shmc;
  const unsigned a_base = lds0 + wr * 8192 + lds_byte(fr, fq * 8);
  const unsigned b_base = lds0 + wc * 4096 + lds_byte(fr, fq * 8);
#pragma unroll
  for (int a = 0; a < 2; ++a)
#pragma unroll
    for (int b = 0; b < 2; ++b)
#pragma unroll
      for (int m = 0; m < 4; ++m)
#pragma unroll
        for (int n = 0; n < 2; ++n) acc[a][b][m][n] = (f32x4){0.f, 0.f, 0.f, 0.f};
  bf16x8 At[4][2], B0[2][2], B1[2][2];
  constexpr int nt = K / BK;
  STAGE(SB(0, 0), Bt, 0, 0); STAGE(SA(0, 0), A, 0, 0);
  STAGE(SB(0, 1), Bt, HALF, 0); STAGE(SA(0, 1), A, HALF, 0);
  if (wr == 1) BAR;
  WAIT_V(4); BAR;
  STAGE(SB(1, 0), Bt, 0, 1); STAGE(SA(1, 0), A, 0, 1); STAGE(SB(1, 1), Bt, HALF, 1);
  WAIT_V(6); BAR;
#pragma unroll 1
  for (int t = 0; t < nt - 2; t += 2) {
    LDB(B0, 0, 0); SCHED; LDA(At, 0, 0); STAGE(SA(1, 1), A, HALF, t + 1);
    WAIT_L(8); BAR; TIE(B0); MMA(0, 0, At, B0); BAR; SCHED;
    LDB(B1, 0, 1); STAGE(SB(0, 0), Bt, 0, t + 2);
    BAR; TIE(B1); MMA(0, 1, At, B1); BAR;
    LDA(At, 0, 1); STAGE(SA(0, 0), A, 0, t + 2);
    BAR; TIE(B0); MMA(1, 0, At, B0); BAR; SCHED;
    STAGE(SB(0, 1), Bt, HALF, t + 2);
    WAIT_V(6); BAR; MMA(1, 1, At, B1); BAR;
    LDB(B0, 1, 0); SCHED; LDA(At, 1, 0); STAGE(SA(0, 1), A, HALF, t + 2);
    WAIT_L(8); BAR; TIE(B0); MMA(0, 0, At, B0); BAR; SCHED;
    LDB(B1, 1, 1); STAGE(SB(1, 0), Bt, 0, t + 3);
    BAR; TIE(B1); MMA(0, 1, At, B1); BAR;
    LDA(At, 1, 1); STAGE(SA(1, 0), A, 0, t + 3);
    BAR; TIE(B0); MMA(1, 0, At, B0); BAR; SCHED;
    STAGE(SB(1, 1), Bt, HALF, t + 3);
    WAIT_V(6); BAR; MMA(1, 1, At, B1); BAR;
  }
  { LDB(B0, 0, 0); LDA(At, 0, 0); STAGE(SA(1, 1), A, HALF, nt - 1);
    BAR; TIE(B0); MMA(0, 0, At, B0); BAR;
    LDB(B1, 0, 1); BAR; TIE(B1); MMA(0, 1, At, B1); BAR;
    LDA(At, 0, 1); WAIT_V(4); BAR; TIE(B0); MMA(1, 0, At, B0); MMA(1, 1, At, B1); BAR; }
  { LDB(B0, 1, 0); LDA(At, 1, 0); WAIT_V(2); BAR; TIE(B0); MMA(0, 0, At, B0); BAR;
    LDB(B1, 1, 1); WAIT_V(0); BAR; TIE(B1); MMA(0, 1, At, B1); BAR;
    LDA(At, 1, 1); BAR; TIE(B0); MMA(1, 0, At, B0); MMA(1, 1, At, B1); BAR; }
  if (wr == 0) BAR;
#undef SA
#undef SB
#undef STAGE
#undef LDA
#undef LDB
#undef TIE
#undef MMA
}

DI void phase_in(const Params& p, int l, char* smem) {
  ushort_t* UG = (ushort_t*)(p.ws + WS_UG);
  ushort_t* Qb = (ushort_t*)(p.ws + WS_Q);
  ushort_t* Kb = (ushort_t*)(p.ws + WS_K);
  ushort_t* GB = (ushort_t*)(p.ws + WS_GB);
  ushort_t* VNT = (ushort_t*)(p.ws + WS_VNT);
  ushort_t* VNS = (ushort_t*)(p.ws + WS_VNS);
  ushort_t* VT = (ushort_t*)(p.ws + WS_VT);
  ushort_t* KSB = (ushort_t*)(p.ws + WS_KSB);
  ushort_t* VTS = (ushort_t*)(p.ws + WS_VTS);
  const ushort_t* XB = (const ushort_t*)(p.ws + WS_XB);
  const float* ssq = (const float*)(p.ws + WS_SSQ) + (size_t)l * TT;
  const ushort_t* Wt = (const ushort_t*)(p.ws + WS_WIN) + (size_t)l * NIN * DM;
  float* ex = (float*)(smem + EX_OFF);
  const int G = gridDim.x;
  constexpr int NTILES = 65 * 14;

  for (int id = blockIdx.x; id < NTILES; id += G) {
    int mt, ntile;
    if (id >= 242 && id < 256) { mt = 64; ntile = id - 242; }
    else {
      const int id2 = (id < 242) ? id : id - 14, grp = id2 / (8 * 14), rem = id2 % (8 * 14);
      mt = grp * 8 + (rem & 7); ntile = rem >> 3;
    }
    const float ssq_mine = ssq[mt * 256 + (tidx(p) & 255)];
    f32x4 acc[2][2][4][2];
    gemm256(Wt + (size_t)ntile * 256 * 1024, XB + (size_t)mt * 256 * 1024, acc, smem, tidx(p));

    int t_ = tidx(p); asm volatile("" : "+v"(t_));
    const int tid = t_, wid = tid >> 6, lane = tid & 63, wr = wid >> 2, wc = wid & 3, fr = lane & 15, fq = lane >> 4;
    const bool samp = (mt == 64);
    float* rsl = (float*)(smem + RS_OFF);
    if (tid < 256) rsl[tid] = rsqrtf(ssq_mine * (1.f / 1024.f) + EPS);
    LDS_BARRIER();
    float rs[2][2]; int tok[2][2];
#pragma unroll
    for (int bj = 0; bj < 2; ++bj)
#pragma unroll
      for (int n = 0; n < 2; ++n) {
        const int tl_ = bj * 128 + wc * 32 + n * 16 + fr;
        tok[bj][n] = mt * 256 + tl_;
        rs[bj][n] = rsl[tl_];
      }
    const int sc00 = wr * 64 + fq * 4;

    if (!samp) {
      const int pb = (mt * 256) >> 11, tt0 = (mt * 256) & 2047;
      int tokl[2][2];
#pragma unroll
      for (int bj = 0; bj < 2; ++bj)
#pragma unroll
        for (int n = 0; n < 2; ++n) tokl[bj][n] = bj * 128 + wc * 32 + n * 16 + fr;
      const bool oddl = (fr & 1) != 0;
      auto store_rows = [&](ushort_t* gdst) {
        LDS_BARRIER();
#pragma unroll
        for (int i = 0; i < 8; ++i) {
          const int idx = tid + 512 * i, row = idx >> 4, c = idx & 15;
          const u32x4 v = *(const u32x4*)(smem + row * 272 + c * 16);
          *(u32x4*)(gdst + (size_t)row * 512 + c * 8) = v;
        }
        LDS_BARRIER();
      };
      auto store_tr = [&](ushort_t* gdst) {
        LDS_BARRIER();
#pragma unroll
        for (int i = 0; i < 8; ++i) {
          const int idx = tid + 512 * i, d = idx >> 5, c = idx & 31;
          const u32x4 v = *(const u32x4*)(smem + d * 528 + c * 16);
          *(u32x4*)(gdst + (size_t)d * 2048 + c * 8) = v;
        }
        LDS_BARRIER();
      };
      auto tr_write = [&](int pos, int sc0, unsigned o0, unsigned o1) {
        const unsigned snd = oddl ? o0 : o1;
        const unsigned rcv = (unsigned)__builtin_amdgcn_mov_dpp((int)snd, 0xB1, 0xF, 0xF, true);
        unsigned w0, w1; int d;
        if (!oddl) { w0 = (o0 & 0xffffu) | (rcv << 16); w1 = (o0 >> 16) | (rcv & 0xffff0000u); d = sc0; }
        else { w0 = (rcv & 0xffffu) | (o1 << 16); w1 = (rcv >> 16) | (o1 & 0xffff0000u); d = sc0 + 2; }
        char* ip = smem + d * 528 + (pos >> 1) * 4;
        *(unsigned*)ip = w0; *(unsigned*)(ip + 528) = w1;
      };
      if (ntile < 4) {
        const int cb = ntile * 128;
#pragma unroll
        for (int bj = 0; bj < 2; ++bj)
#pragma unroll
          for (int n = 0; n < 2; ++n) {
            const float r = rs[bj][n];
#pragma unroll
            for (int m = 0; m < 4; ++m) {
              const f32x4 u = acc[0][bj][m][n] * r, g = acc[1][bj][m][n] * r;
              u32x2 o; o.x = pk(u.x * silu(g.x), u.y * silu(g.y)); o.y = pk(u.z * silu(g.z), u.w * silu(g.w));
              *(u32x2*)(smem + tokl[bj][n] * 272 + (sc00 + m * 16) * 2) = o;
            }
          }
        store_rows(UG + (size_t)(mt * 256) * 512 + cb);
      } else if (ntile < 6) {
        float part[2][2][2];
#pragma unroll
        for (int ai = 0; ai < 2; ++ai)
#pragma unroll
          for (int bj = 0; bj < 2; ++bj)
#pragma unroll
            for (int n = 0; n < 2; ++n) {
              float sq = 0.f;
#pragma unroll
              for (int m = 0; m < 4; ++m) {
                const f32x4 v = acc[ai][bj][m][n];
                sq += v.x * v.x + v.y * v.y + v.z * v.z + v.w * v.w;
              }
              sq += __shfl_xor(sq, 16); sq += __shfl_xor(sq, 32);
              part[ai][bj][n] = sq;
              if (fq == 0) ex[((wid * 2 + ai) * 4 + bj * 2 + n) * 16 + fr] = sq;
            }
        __syncthreads();
#pragma unroll
        for (int ai = 0; ai < 2; ++ai) {
          const int head = 2 * (ntile - 4) + ai;
          const float* gp = p.sgu_norm_g + l * 512 + head * 128;
#pragma unroll
          for (int bj = 0; bj < 2; ++bj)
#pragma unroll
            for (int n = 0; n < 2; ++n) {
              const float r = rs[bj][n];
              const float tot = (part[ai][bj][n] + ex[(((wid ^ 4) * 2 + ai) * 4 + bj * 2 + n) * 16 + fr]) * r * r;
              const float rn = rsqrtf(tot * (1.f / 128.f) + EPS) * r;
#pragma unroll
              for (int m = 0; m < 4; ++m) {
                const int sc0 = sc00 + m * 16;
                const f32x4 v = acc[ai][bj][m][n];
                const f32x4 gg = *(const f32x4*)(gp + sc0);
                tr_write(tokl[bj][n], sc0, pk(v.x * rn * gg.x, v.y * rn * gg.y), pk(v.z * rn * gg.z, v.w * rn * gg.w));
              }
            }
          store_tr(VNT + ((size_t)(pb * 4 + head) * 128) * 2048 + tt0);
        }
      } else if (ntile < 10) {
        const int head = ntile - 6, cb = head * 128;
#pragma unroll
        for (int ai = 0; ai < 2; ++ai) {
          const float* gp = (ai == 0 ? p.q_norm_g : p.k_norm_g) + l * 64;
#pragma unroll
          for (int bj = 0; bj < 2; ++bj)
#pragma unroll
            for (int n = 0; n < 2; ++n) {
              float sq = 0.f;
#pragma unroll
              for (int m = 0; m < 4; ++m) {
                const f32x4 v = acc[ai][bj][m][n];
                sq += v.x * v.x + v.y * v.y + v.z * v.z + v.w * v.w;
              }
              sq += __shfl_xor(sq, 16); sq += __shfl_xor(sq, 32);
              const float r = rs[bj][n];
              const float rn = rsqrtf(sq * r * r * (1.f / 64.f) + EPS) * r * (ai == 0 ? 0.125f * LOG2E : 1.f);
              const int tk = tok[bj][n];
#pragma unroll
              for (int m = 0; m < 4; ++m) {
                const int sc0 = sc00 + m * 16;
                const f32x4 gg = *(const f32x4*)(gp + fq * 4 + m * 16);
                const f32x4 v = acc[ai][bj][m][n] * rn * gg;
                u32x2 o; o.x = pk(v.x, v.y); o.y = pk(v.z, v.w);
                if (ai == 1) __builtin_nontemporal_store(v, (f32x4*)(p.out + OKP + (size_t)l * 8388608 + (size_t)tk * 512 + cb + sc0));
                *(u32x2*)(smem + tokl[bj][n] * 272 + sc0 * 2) = o;
              }
            }
          store_rows((ai == 0 ? Qb : Kb) + (size_t)(mt * 256) * 512 + cb);
        }
      } else {
        const int head = ntile - 10, cb = head * 128;
#pragma unroll
        for (int bj = 0; bj < 2; ++bj)
#pragma unroll
          for (int n = 0; n < 2; ++n) {
            const float r = rs[bj][n];
            const int tk = tok[bj][n];
            const int tl = tokl[bj][n];
            const int pos = (tl & ~15) + kperm(tl & 15);
#pragma unroll
            for (int m = 0; m < 4; ++m) {
              const int sc0 = sc00 + m * 16;
              const f32x4 v = acc[0][bj][m][n] * r;
              __builtin_nontemporal_store(v, (f32x4*)(p.out + OVP + (size_t)l * 8388608 + (size_t)tk * 512 + cb + sc0));
              tr_write(pos, sc0, pk(v.x, v.y), pk(v.z, v.w));
            }
          }
        store_tr(VT + ((size_t)(pb * 4 + head) * 128) * 2048 + tt0);
#pragma unroll
        for (int bj = 0; bj < 2; ++bj)
#pragma unroll
          for (int n = 0; n < 2; ++n) {
            const float r = rs[bj][n];
#pragma unroll
            for (int m = 0; m < 4; ++m) {
              const f32x4 g = acc[1][bj][m][n] * r;
              u32x2 o; o.x = pk(silu(g.x), silu(g.y)); o.y = pk(silu(g.z), silu(g.w));
              *(u32x2*)(smem + tokl[bj][n] * 272 + (sc00 + m * 16) * 2) = o;
            }
          }
        store_rows(GB + (size_t)(mt * 256) * 512 + cb);
      }
      continue;
    }
    if (ntile < 4) {
      const int cb = ntile * 128;
#pragma unroll
      for (int bj = 0; bj < 2; ++bj)
#pragma unroll
        for (int n = 0; n < 2; ++n) {
          const float r = rs[bj][n];
#pragma unroll
          for (int m = 0; m < 4; ++m) {
            const f32x4 u = acc[0][bj][m][n] * r, g = acc[1][bj][m][n] * r;
            u32x2 o; o.x = pk(u.x * silu(g.x), u.y * silu(g.y)); o.y = pk(u.z * silu(g.z), u.w * silu(g.w));
            *(u32x2*)(UG + (size_t)tok[bj][n] * 512 + cb + sc00 + m * 16) = o;
          }
        }
    } else if (ntile < 6) {
      float part[2][2][2];
#pragma unroll
      for (int ai = 0; ai < 2; ++ai)
#pragma unroll
        for (int bj = 0; bj < 2; ++bj)
#pragma unroll
          for (int n = 0; n < 2; ++n) {
            float s = 0.f;
#pragma unroll
            for (int m = 0; m < 4; ++m) {
              const f32x4 v = acc[ai][bj][m][n];
              s += v.x * v.x + v.y * v.y + v.z * v.z + v.w * v.w;
            }
            s += __shfl_xor(s, 16); s += __shfl_xor(s, 32);
            part[ai][bj][n] = s;
            if (fq == 0) ex[((wid * 2 + ai) * 4 + bj * 2 + n) * 16 + fr] = s;
          }
      __syncthreads();
#pragma unroll
      for (int ai = 0; ai < 2; ++ai) {
        const int head = 2 * (ntile - 4) + ai;
        const int cb = head * 128;
        const float* gp = p.sgu_norm_g + l * 512 + cb;
#pragma unroll
        for (int bj = 0; bj < 2; ++bj)
#pragma unroll
          for (int n = 0; n < 2; ++n) {
            const float r = rs[bj][n];
            const float tot = (part[ai][bj][n] + ex[(((wid ^ 4) * 2 + ai) * 4 + bj * 2 + n) * 16 + fr]) * r * r;
            const float rn = rsqrtf(tot * (1.f / 128.f) + EPS) * r;
            const int tk = tok[bj][n];
#pragma unroll
            for (int m = 0; m < 4; ++m) {
              const int sc0 = sc00 + m * 16;
              const f32x4 v = acc[ai][bj][m][n];
              const f32x4 gg = *(const f32x4*)(gp + sc0);
              const unsigned o0 = pk(v.x * rn * gg.x, v.y * rn * gg.y), o1 = pk(v.z * rn * gg.z, v.w * rn * gg.w);
              if (samp) {
                const int rs_ = tk - TP;
                *(f32x4*)(p.out + OSGU + (size_t)l * 131072 + (size_t)rs_ * 512 + cb + sc0) = v * r;
                u32x2 o; o.x = o0; o.y = o1;
                *(u32x2*)(VNS + (size_t)rs_ * 512 + cb + sc0) = o;
              } else {
                const int b = tk >> 11, tt = tk & 2047;
                ushort_t* vb = VNT + ((size_t)(b * 4 + head) * 128 + sc0) * 2048 + tt;
                vb[0] = (ushort_t)(o0 & 0xffff); vb[2048] = (ushort_t)(o0 >> 16);
                vb[4096] = (ushort_t)(o1 & 0xffff); vb[6144] = (ushort_t)(o1 >> 16);
              }
            }
          }
      }
      __syncthreads();
    } else if (ntile < 10) {
      const int head = ntile - 6, cb = head * 128;
#pragma unroll
      for (int ai = 0; ai < 2; ++ai) {
        const float* gp = (ai == 0 ? p.q_norm_g : p.k_norm_g) + l * 64;
#pragma unroll
        for (int bj = 0; bj < 2; ++bj)
#pragma unroll
          for (int n = 0; n < 2; ++n) {
            float s = 0.f;
#pragma unroll
            for (int m = 0; m < 4; ++m) {
              const f32x4 v = acc[ai][bj][m][n];
              s += v.x * v.x + v.y * v.y + v.z * v.z + v.w * v.w;
            }
            s += __shfl_xor(s, 16); s += __shfl_xor(s, 32);
            const float r = rs[bj][n];
            const float rn = rsqrtf(s * r * r * (1.f / 64.f) + EPS) * r * (ai == 0 ? 0.125f * LOG2E : 1.f);
            const int tk = tok[bj][n];
#pragma unroll
            for (int m = 0; m < 4; ++m) {
              const int sc0 = sc00 + m * 16;
              const f32x4 gg = *(const f32x4*)(gp + fq * 4 + m * 16);
              const f32x4 v = acc[ai][bj][m][n] * rn * gg;
              u32x2 o; o.x = pk(v.x, v.y); o.y = pk(v.z, v.w);
              if (ai == 0) {
                *(u32x2*)(Qb + (size_t)tk * 512 + cb + sc0) = o;
              } else if (samp) {
                const int rs_ = tk - TP, b = rs_ >> 4, tq = rs_ & 15;
                *(f32x4*)(p.out + OKS + (size_t)l * 131072 + (size_t)rs_ * 512 + cb + sc0) = v;
                *(u32x2*)(KSB + ((size_t)(l * 16 + b) * SROWS + 1024 + tq) * 512 + cb + sc0) = o;
              } else {
                *(f32x4*)(p.out + OKP + (size_t)l * 8388608 + (size_t)tk * 512 + cb + sc0) = v;
                *(u32x2*)(Kb + (size_t)tk * 512 + cb + sc0) = o;
              }
            }
          }
      }
    } else {
      const int head = ntile - 10, cb = head * 128;
#pragma unroll
      for (int bj = 0; bj < 2; ++bj)
#pragma unroll
        for (int n = 0; n < 2; ++n) {
          const float r = rs[bj][n];
          const int tk = tok[bj][n];
#pragma unroll
          for (int m = 0; m < 4; ++m) {
            const int sc0 = sc00 + m * 16;
            const f32x4 v = acc[0][bj][m][n] * r;
            const unsigned o0 = pk(v.x, v.y), o1 = pk(v.z, v.w);
            if (samp) {
              const int rs_ = tk - TP, b = rs_ >> 4, tq = rs_ & 15;
              *(f32x4*)(p.out + OVS + (size_t)l * 131072 + (size_t)rs_ * 512 + cb + sc0) = v;
              ushort_t* vb = VTS + ((size_t)((l * 16 + b) * 4 + head) * 128 + sc0) * SROWS + 1024 + kperm(tq);
              vb[0] = (ushort_t)(o0 & 0xffff); vb[SROWS] = (ushort_t)(o0 >> 16);
              vb[2 * SROWS] = (ushort_t)(o1 & 0xffff); vb[3 * SROWS] = (ushort_t)(o1 >> 16);
            } else {
              *(f32x4*)(p.out + OVP + (size_t)l * 8388608 + (size_t)tk * 512 + cb + sc0) = v;
              const int b = tk >> 11, tt = tk & 2047;
              ushort_t* vb = VT + ((size_t)(b * 4 + head) * 128 + sc0) * 2048 + (tt & ~15) + kperm(tt & 15);
              vb[0] = (ushort_t)(o0 & 0xffff); vb[2048] = (ushort_t)(o0 >> 16);
              vb[4096] = (ushort_t)(o1 & 0xffff); vb[6144] = (ushort_t)(o1 >> 16);
            }
            const f32x4 g = acc[1][bj][m][n] * r;
            u32x2 o; o.x = pk(silu(g.x), silu(g.y)); o.y = pk(silu(g.z), silu(g.w));
            *(u32x2*)(GB + (size_t)tk * 512 + cb + sc0) = o;
          }
        }
    }
  }
}

DI void attn_unit(const Params& p, int l, const ushort_t* Kp, const ushort_t* Vp, int vstride, int qrow0, int qpos0,
                  int ntiles, int head, bool sample, char* smem, float lam, float M2, float oscale) {
  int t_ = tidx(p); asm volatile("" : "+v"(t_));
  const int t = t_, lane = t & 63, w = t >> 6, l31 = lane & 31, h = lane >> 5;
  const int rg = sample ? (w >> 1) : (w & 3), hc = sample ? (w & 1) : (w >> 2);
  const ushort_t* Qb = (const ushort_t*)(p.ws + WS_Q);
  const ushort_t* GB = (const ushort_t*)(p.ws + WS_GB);
  ushort_t* Y = (ushort_t*)(p.ws + WS_Y);

  int qrow, qpos, mytiles;
  if (sample) { qrow = qrow0 + (l31 & 15); qpos = qpos0 + (l31 & 15); mytiles = (rg == 0) ? ntiles : 0; }
  else { qrow = qrow0 + rg * 32 + l31; qpos = qpos0 + rg * 32 + l31; mytiles = ntiles - 1 + (rg >> 1); }
  const int diagtile = sample ? 16 : (qpos0 >> 6) + (rg >> 1);
  bf16x8 qf[4];
#pragma unroll
  for (int ks = 0; ks < 4; ++ks) qf[ks] = *(const bf16x8*)(Qb + (size_t)qrow * 512 + head * 128 + hc * 64 + ks * 16 + h * 8);
  const float slope2 = exp2f(-2.f * (float)(head + 1)) * LOG2E;

  f32x16 ot[4];
#pragma unroll
  for (int dt = 0; dt < 4; ++dt)
#pragma unroll
    for (int i = 0; i < 16; ++i) ot[dt][i] = 0.f;
  float lsum = 0.f;

  const unsigned lds0 = (unsigned)(size_t)smem;
  unsigned koff[4], voff[4];
#pragma unroll
  for (int x = 0; x < 4; ++x) {
    koff[x] = (unsigned)(l31 * 256 + (((hc * 8 + x * 2 + h) ^ (l31 & 15)) * 16));
    voff[x] = (unsigned)(l31 * 128 + (((x * 2 + h) ^ ((l31 >> 1) & 7)) * 16));
  }
  unsigned ksrc[2], vsrc[2];
#pragma unroll
  for (int i = 0; i < 2; ++i) {
    const int o = t * 16 + i * 8192;
    const int row = o >> 8, cp = (o >> 4) & 15;
    ksrc[i] = (unsigned)(row * 512 + ((cp ^ (row & 15)) * 8)) * 2u;
    const int d = o >> 7, cv = (o >> 4) & 7;
    vsrc[i] = (unsigned)(d * vstride + ((cv ^ ((d >> 1) & 7)) * 8)) * 2u;
  }
  auto issue = [&](int j) {
    char* slot = smem + (j & 3) * 32768;
    if (sample) {
#pragma unroll
      for (int i = 0; i < 2; ++i) GLDS_NT((const char*)(Kp + (size_t)j * 64 * 512) + ksrc[i], slot + t * 16 + i * 8192);
#pragma unroll
      for (int i = 0; i < 2; ++i) GLDS_NT((const char*)(Vp + (size_t)j * 64) + vsrc[i], slot + 16384 + t * 16 + i * 8192);
      return;
    }
#pragma unroll
    for (int i = 0; i < 2; ++i) GLDS((const char*)(Kp + (size_t)j * 64 * 512) + ksrc[i], slot + t * 16 + i * 8192);
#pragma unroll
    for (int i = 0; i < 2; ++i) GLDS((const char*)(Vp + (size_t)j * 64) + vsrc[i], slot + 16384 + t * 16 + i * 8192);
  };
#define VREAD(dst, sl, x) do { const unsigned _a = (sl) + voff[x]; \
    DSR(dst[0], _a, 16384); DSR(dst[1], _a, 20480); DSR(dst[2], _a, 24576); DSR(dst[3], _a, 28672); } while (0)
#define VWAIT(n, v) asm volatile("s_waitcnt lgkmcnt(" #n ")" : "+v"(v[0]), "+v"(v[1]), "+v"(v[2]), "+v"(v[3]))
#define PVMMA(v, s2) do { _Pragma("unroll") for (int dt = 0; dt < 4; ++dt) ot[dt] = MFMA32(v[dt], pf[s2], ot[dt]); } while (0)
#define EXP8(kt, o8) do { _Pragma("unroll") for (int i = (o8); i < (o8) + 8; ++i) { \
    const float pv = __builtin_amdgcn_exp2f(st[kt][i]); lsum += pv; st[kt][i] = pv; } } while (0)

  asm volatile("" : "+v"(qf[0]), "+v"(qf[1]), "+v"(qf[2]), "+v"(qf[3]));
  __syncthreads();
  issue(0);
  if (ntiles > 1) issue(1);
  bf16x8 pf[4];
#pragma unroll
  for (int x = 0; x < 4; ++x) pf[x] = (bf16x8){0, 0, 0, 0, 0, 0, 0, 0};
#pragma unroll 1
  for (int j = 0; j <= ntiles; ++j) {
    if (j + 1 < ntiles) { WAIT_V(4); } else { WAIT_V(0); }
    BAR;
    if (j + 2 < ntiles) issue(j + 2);
    const bool doqk = (j < mytiles), dopv = (j >= 1 && j <= mytiles);
    const unsigned slot = lds0 + (unsigned)(j & 3) * 32768u;
    const unsigned pslot = lds0 + (unsigned)((j + 3) & 3) * 32768u;
    f32x16 st[2];
    bf16x8 va[4], vb[4];
    if (dopv) { VREAD(va, pslot, 0); VREAD(vb, pslot, 1); }
    if (doqk) {
      const int dq = qpos - 64 * j - 4 * h;
      bf16x8 ka[4], kb[4];
      {
        const unsigned a0 = slot + koff[0], a1 = slot + koff[1], a2 = slot + koff[2], a3 = slot + koff[3];
        DSR(ka[0], a0, 0); DSR(ka[1], a0, 8192); DSR(ka[2], a1, 0); DSR(ka[3], a1, 8192);
        DSR(kb[0], a2, 0); DSR(kb[1], a2, 8192); DSR(kb[2], a3, 0); DSR(kb[3], a3, 8192);
      }
      if (j < diagtile) {
        const float base = -slope2 * (float)dq - M2;
        float be[4];
#pragma unroll
        for (int e = 0; e < 4; ++e) be[e] = fmaf(slope2, (float)e, base);
#pragma unroll
        for (int kt = 0; kt < 2; ++kt)
#pragma unroll
          for (int g = 0; g < 4; ++g) {
            const float cs = __int_as_float(__builtin_amdgcn_readfirstlane(__float_as_int(slope2 * (float)(32 * kt + 8 * g))));
#pragma unroll
            for (int e = 0; e < 4; ++e) {
              float r;
              asm("v_add_f32 %0, %1, %2" : "=v"(r) : "s"(cs), "v"(be[e]));
              st[kt][4 * g + e] = r;
            }
          }
      } else {
        const bool lastmask = sample && (j == ntiles - 1);
#pragma unroll
        for (int kt = 0; kt < 2; ++kt)
#pragma unroll
          for (int i = 0; i < 16; ++i) {
            const int off = 32 * kt + 8 * (i >> 2) + (i & 3);
            const int dd = dq - off;
            float bv = -slope2 * (float)(dd < 0 ? -dd : dd) - M2;
            if (lastmask && (kt == 1 || (i >> 2) >= 2)) bv = -1e30f;
            st[kt][i] = bv;
          }
      }
      asm volatile("s_waitcnt lgkmcnt(4)" : "+v"(ka[0]), "+v"(ka[1]), "+v"(ka[2]), "+v"(ka[3]));
      st[0] = MFMA32(ka[0], qf[0], st[0]); st[1] = MFMA32(ka[1], qf[0], st[1]);
      st[0] = MFMA32(ka[2], qf[1], st[0]); st[1] = MFMA32(ka[3], qf[1], st[1]);
      asm volatile("s_waitcnt lgkmcnt(0)" : "+v"(kb[0]), "+v"(kb[1]), "+v"(kb[2]), "+v"(kb[3]));
      st[0] = MFMA32(kb[0], qf[2], st[0]); st[1] = MFMA32(kb[1], qf[2], st[1]);
      st[0] = MFMA32(kb[2], qf[3], st[0]); st[1] = MFMA32(kb[3], qf[3], st[1]);
    }
    if (doqk && dopv) {
      VWAIT(0, va); PVMMA(va, 0); EXP8(0, 0);
      VREAD(va, pslot, 2);
      VWAIT(4, vb); PVMMA(vb, 1); EXP8(0, 8);
      VREAD(vb, pslot, 3);
      VWAIT(4, va); PVMMA(va, 2); EXP8(1, 0);
      VWAIT(0, vb); PVMMA(vb, 3); EXP8(1, 8);
    } else if (doqk) {
      EXP8(0, 0); EXP8(0, 8); EXP8(1, 0); EXP8(1, 8);
    } else if (dopv) {
      VWAIT(4, va); PVMMA(va, 0);
      VREAD(va, pslot, 2);
      VWAIT(4, vb); PVMMA(vb, 1);
      VREAD(vb, pslot, 3);
      VWAIT(4, va); PVMMA(va, 2);
      VWAIT(0, vb); PVMMA(vb, 3);
    }
    if (doqk) {
#pragma unroll
      for (int s2 = 0; s2 < 4; ++s2) {
        const int kt = s2 >> 1, o8 = 8 * (s2 & 1);
        union { u32x4 u; bf16x8 v; } cv;
        cv.u.x = pk(st[kt][o8 + 0], st[kt][o8 + 1]);
        cv.u.y = pk(st[kt][o8 + 2], st[kt][o8 + 3]);
        cv.u.z = pk(st[kt][o8 + 4], st[kt][o8 + 5]);
        cv.u.w = pk(st[kt][o8 + 6], st[kt][o8 + 7]);
        pf[s2] = cv.v;
      }
    }
  }
#undef VREAD
#undef VWAIT
#undef PVMMA
#undef EXP8

  lsum += __shfl_xor(lsum, 32);
  const float inv = 1.f / lsum;
  __syncthreads();
  float* Ol = (float*)smem;
  if (hc == 1) {
    const float sc = lam * inv;
#pragma unroll
    for (int dt = 0; dt < 4; ++dt)
#pragma unroll
      for (int g = 0; g < 4; ++g) {
        const int d0 = 32 * dt + 8 * g + 4 * h;
        f32x4 v = {ot[dt][4 * g] * sc, ot[dt][4 * g + 1] * sc, ot[dt][4 * g + 2] * sc, ot[dt][4 * g + 3] * sc};
        *(f32x4*)(Ol + (rg * 32 + l31) * 132 + d0) = v;
      }
  }
  __syncthreads();
  if (hc == 0) {
    float ssq = 0.f;
#pragma unroll
    for (int dt = 0; dt < 4; ++dt)
#pragma unroll
      for (int g = 0; g < 4; ++g) {
        const int d0 = 32 * dt + 8 * g + 4 * h;
        const f32x4 v2 = *(const f32x4*)(Ol + (rg * 32 + l31) * 132 + d0);
        ot[dt][4 * g + 0] = ot[dt][4 * g + 0] * inv - v2.x;
        ot[dt][4 * g + 1] = ot[dt][4 * g + 1] * inv - v2.y;
        ot[dt][4 * g + 2] = ot[dt][4 * g + 2] * inv - v2.z;
        ot[dt][4 * g + 3] = ot[dt][4 * g + 3] * inv - v2.w;
        ssq += ot[dt][4 * g] * ot[dt][4 * g] + ot[dt][4 * g + 1] * ot[dt][4 * g + 1] + ot[dt][4 * g + 2] * ot[dt][4 * g + 2] +
               ot[dt][4 * g + 3] * ot[dt][4 * g + 3];
      }
    ssq += __shfl_xor(ssq, 32);
    const float rn = rsqrtf(ssq * (1.f / 128.f) + EPS) * oscale;
    const bool valid = sample ? (rg == 0 && l31 < 16) : true;
    const float* sg = p.subln_g + l * 128;
    ushort_t* yrow = Y + (size_t)qrow * 1024 + 512 + head * 128;
    const ushort_t* gbrow = GB + (size_t)qrow * 512 + head * 128;
#pragma unroll
    for (int dt = 0; dt < 4; ++dt)
#pragma unroll
      for (int gp = 0; gp < 2; ++gp) {
        u32x2 og[2];
#pragma unroll
        for (int q = 0; q < 2; ++q) {
          const int g = 2 * gp + q;
          const int d0 = 32 * dt + 8 * g + 4 * h;
          const u32x2 gb = *(const u32x2*)(gbrow + d0);
          const f32x4 gg = *(const f32x4*)(sg + d0);
          og[q].x = pk(ot[dt][4 * g] * rn * gg.x * bflo(gb.x), ot[dt][4 * g + 1] * rn * gg.y * bfhi(gb.x));
          og[q].y = pk(ot[dt][4 * g + 2] * rn * gg.z * bflo(gb.y), ot[dt][4 * g + 3] * rn * gg.w * bfhi(gb.y));
        }
        const u32x2 snd = h ? og[0] : og[1];
        u32x2 rcv;
        rcv.x = (unsigned)__shfl_xor((int)snd.x, 32);
        rcv.y = (unsigned)__shfl_xor((int)snd.y, 32);
        u32x4 o16;
        if (h == 0) { o16.x = og[0].x; o16.y = og[0].y; o16.z = rcv.x; o16.w = rcv.y; }
        else { o16.x = rcv.x; o16.y = rcv.y; o16.z = og[1].x; o16.w = og[1].y; }
        if (valid) *(u32x4*)(yrow + 32 * dt + 16 * gp + 8 * h) = o16;
      }
  }
}

DI void sgu_unit(const Params& p, int l, int b, int n, int head, char* smem) {
  int t_ = tidx(p); asm volatile("" : "+v"(t_));
  const int t = t_, lane = t & 63, w = t >> 6, l31 = lane & 31, h = lane >> 5;
  const int dtile = w & 3, th = w >> 2;
  const ushort_t* UG = (const ushort_t*)(p.ws + WS_UG);
  const ushort_t* VNT = (const ushort_t*)(p.ws + WS_VNT);
  ushort_t* Y = (ushort_t*)(p.ws + WS_Y);
  char* Wl = smem;
  const float* W = p.sgu_w + (size_t)(l * 4 + head) * 128 * 128;
  __syncthreads();
#pragma unroll
  for (int i = 0; i < 4; ++i) {
    const int f = t + 512 * i, row = f >> 4, c8 = f & 15;
    f32x4 a = *(const f32x4*)(W + row * 128 + c8 * 8);
    f32x4 bq = *(const f32x4*)(W + row * 128 + c8 * 8 + 4);
    const int s0 = c8 * 8;
    if (s0 + 0 > row) a.x = 0.f; if (s0 + 1 > row) a.y = 0.f; if (s0 + 2 > row) a.z = 0.f; if (s0 + 3 > row) a.w = 0.f;
    if (s0 + 4 > row) bq.x = 0.f; if (s0 + 5 > row) bq.y = 0.f; if (s0 + 6 > row) bq.z = 0.f; if (s0 + 7 > row) bq.w = 0.f;
    *(u32x4*)(Wl + row * 272 + c8 * 16) = pk8(a, bq);
  }
  bf16x8 af[8];
#pragma unroll
  for (int ks = 0; ks < 8; ++ks)
    af[ks] = *(const bf16x8*)(VNT + ((size_t)(b * 4 + head) * 128 + 32 * dtile + l31) * 2048 + n * 128 + ks * 16 + h * 8);
  __syncthreads();
  f32x16 acc[2];
#pragma unroll
  for (int q = 0; q < 2; ++q) {
#pragma unroll
    for (int i = 0; i < 16; ++i) acc[q][i] = 0.f;
#pragma unroll
    for (int ks = 0; ks < 8; ++ks) {
      if (ks <= 4 * th + 2 * q + 1) {
        const bf16x8 bw = *(const bf16x8*)(Wl + (32 * (2 * th + q) + l31) * 272 + ks * 32 + h * 16);
        acc[q] = MFMA32(af[ks], bw, acc[q]);
      }
    }
  }
#pragma unroll
  for (int q = 0; q < 2; ++q) {
    const int tt = 32 * (2 * th + q) + l31;
    const size_t r = (size_t)b * 2048 + n * 128 + tt;
    const float bias = p.sgu_b[(l * 4 + head) * 128 + tt];
#pragma unroll
    for (int g = 0; g < 4; ++g) {
      const int d0 = 32 * dtile + 8 * g + 4 * h;
      const u32x2 u = *(const u32x2*)(UG + r * 512 + head * 128 + d0);
      u32x2 o;
      o.x = pk((acc[q][4 * g] + bias) * bflo(u.x), (acc[q][4 * g + 1] + bias) * bfhi(u.x));
      o.y = pk((acc[q][4 * g + 2] + bias) * bflo(u.y), (acc[q][4 * g + 3] + bias) * bfhi(u.y));
      *(u32x2*)(Y + r * 1024 + head * 128 + d0) = o;
    }
  }
}

DI void sgu_sample_unit(const Params& p, int l, int b, int head) {
  const int t = tidx(p);
  const ushort_t* UG = (const ushort_t*)(p.ws + WS_UG);
  const ushort_t* VNS = (const ushort_t*)(p.ws + WS_VNS);
  ushort_t* Y = (ushort_t*)(p.ws + WS_Y);
  const float* W = p.sgu_w + (size_t)(l * 4 + head) * 128 * 128;
  for (int idx = t; idx < 2048; idx += 512) {
    const int tt = idx >> 7, d = idx & 127, col = head * 128 + d;
    float wv[16], vv[16];
#pragma unroll
    for (int q = 0; q < 16; ++q) {
      wv[q] = W[tt * 128 + q];
      vv[q] = bflo((unsigned)VNS[(size_t)(b * 16 + q) * 512 + col]);
    }
    float a = p.sgu_b[(l * 4 + head) * 128 + tt];
#pragma unroll
    for (int q = 0; q < 16; ++q) a += (q <= tt) ? wv[q] * vv[q] : 0.f;
    const size_t r = (size_t)TP + b * 16 + tt;
    const float y = a * bflo((unsigned)UG[r * 512 + col]);
    Y[r * 1024 + col] = (ushort_t)(pk(y, y) & 0xffff);
  }
}

DI void phase_mix(const Params& p, int l, char* smem, int* s_item) {
  const float* par = (const float*)(p.ws + WS_PAR);
  const float lam = par[l * 4 + 0], M2 = par[l * 4 + 1], oscale = par[l * 4 + 2];
  const int G = gridDim.x;
  const ushort_t* Kb = (const ushort_t*)(p.ws + WS_K);
  const ushort_t* VT = (const ushort_t*)(p.ws + WS_VT);
  const ushort_t* KSB = (const ushort_t*)(p.ws + WS_KSB);
  const ushort_t* VTS = (const ushort_t*)(p.ws + WS_VTS);
  for (int u0 = blockIdx.x; u0 < 256; u0 += G) {
    const int u = ((G & 7) == 0 && G >= 256) ? ((u0 & 7) * 32 + (u0 >> 3)) : u0;
    const int bh = u >> 3, pi = u & 7, b = bh >> 2, head = bh & 3;
#pragma unroll 1
    for (int half = 0; half < 2; ++half) {
      const int qb = half ? pi : 15 - pi;
      attn_unit(p, l, Kb + (size_t)b * 2048 * 512 + head * 128, VT + (size_t)(b * 4 + head) * 128 * 2048, 2048,
                b * 2048 + qb * 128, qb * 128, 2 * qb + 2, head, false, smem, lam, M2, oscale);
    }
  }
  for (int u = blockIdx.x; u < 64; u += G) {
    const int b = u >> 2, head = u & 3;
    attn_unit(p, l, KSB + (size_t)(l * 16 + b) * SROWS * 512 + head * 128, VTS + (size_t)((l * 16 + b) * 4 + head) * 128 * SROWS,
              SROWS, TP + b * 16, 1024, 17, head, true, smem, lam, M2, oscale);
  }
  unsigned* ctr = (unsigned*)(p.ws + WS_PAR) + 16 + l;
  while (true) {
    __syncthreads();
    if (tidx(p) == 0) *s_item = (int)atomicAdd(ctr, 1u);
    __syncthreads();
    const int item = *s_item;
    if (item >= 576) break;
    if (item < 64) sgu_sample_unit(p, l, item >> 2, item & 3);
    else { const int j = item - 64; sgu_unit(p, l, j >> 6, (j >> 2) & 15, j & 3, smem); }
  }
}

DI void phase_out(const Params& p, int l, char* smem) {
  const ushort_t* Y = (const ushort_t*)(p.ws + WS_Y);
  const ushort_t* Wt = (const ushort_t*)(p.ws + WS_WOUT) + (size_t)l * DM * DM;
  ushort_t* XB = (ushort_t*)(p.ws + WS_XB);
  float* ssq1 = (float*)(p.ws + WS_SSQ) + TT;
  const int G = gridDim.x;
  constexpr int NTILES = 64 * 4;
  for (int id = blockIdx.x; id < NTILES; id += G) {
    const int mt = id >> 2, ntile = id & 3;
    f32x4 acc[2][2][4][2];
    gemm256(Wt + (size_t)ntile * 256 * 1024, Y + (size_t)mt * 256 * 1024, acc, smem, tidx(p));
    int t_ = tidx(p); asm volatile("" : "+v"(t_));
    const int tid = t_, wid = tid >> 6, lane = tid & 63, wr = wid >> 2, wc = wid & 3, fr = lane & 15, fq = lane >> 4;
#pragma unroll
    for (int bj = 0; bj < 2; ++bj)
#pragma unroll
      for (int n = 0; n < 2; ++n) {
        const int tk = mt * 256 + bj * 128 + wc * 32 + n * 16 + fr;
        float* orow = p.out + (size_t)tk * 1024;
        float s = 0.f;
#pragma unroll
        for (int ai = 0; ai < 2; ++ai)
#pragma unroll
          for (int m = 0; m < 4; ++m) {
            const int c0 = ntile * 256 + ai * 128 + wr * 64 + m * 16 + fq * 4;
            const u32x2 xb = *(const u32x2*)(XB + (size_t)tk * 1024 + c0);
            f32x4 xv = {bflo(xb.x), bfhi(xb.x), bflo(xb.y), bfhi(xb.y)};
            xv += acc[ai][bj][m][n];
            if (l == 1) __builtin_nontemporal_store(xv, (f32x4*)(orow + c0));
            if (l == 0) {
              s += xv.x * xv.x + xv.y * xv.y + xv.z * xv.z + xv.w * xv.w;
              u32x2 o; o.x = pk(xv.x, xv.y); o.y = pk(xv.z, xv.w);
              *(u32x2*)(XB + (size_t)tk * 1024 + c0) = o;
            }
          }
        if (l == 0) {
          s += __shfl_xor(s, 16); s += __shfl_xor(s, 32);
          if (fq == 0) atomicAdd(ssq1 + tk, s);
        }
      }
  }
  for (int it = blockIdx.x; it < 256; it += G) {
    const int tid = tidx(p), wid = tid >> 6, lane = tid & 63, fr = lane & 15, fq = lane >> 4;
    const int sl = it >> 2, tg = it & 3, tt = wid & 3, kh = wid >> 2;
    const int tk = TP + tg * 64 + tt * 16 + fr;
    const ushort_t* wp = Wt + (size_t)(sl * 16 + fr) * 1024 + kh * 512 + fq * 8;
    const ushort_t* yp = Y + (size_t)tk * 1024 + kh * 512 + fq * 8;
    bf16x8 wf[16], yf[16];
#pragma unroll
    for (int q = 0; q < 16; ++q) { wf[q] = *(const bf16x8*)(wp + q * 32); yf[q] = *(const bf16x8*)(yp + q * 32); }
    f32x4 a0 = {0.f, 0.f, 0.f, 0.f};
#pragma unroll
    for (int q = 0; q < 16; ++q) a0 = MFMA16(wf[q], yf[q], a0);
    float* cx = (float*)smem;
    __syncthreads();
    if (kh == 1) *(f32x4*)(cx + (tt * 64 + lane) * 4) = a0;
    __syncthreads();
    if (kh == 0) {
      a0 += *(const f32x4*)(cx + (tt * 64 + lane) * 4);
      const int c0 = sl * 16 + fq * 4;
      const u32x2 xb = *(const u32x2*)(XB + (size_t)tk * 1024 + c0);
      f32x4 xv = {bflo(xb.x), bfhi(xb.x), bflo(xb.y), bfhi(xb.y)};
      xv += a0;
      if (l == 1) *(f32x4*)(p.out + (size_t)tk * 1024 + c0) = xv;
      if (l == 0) {
        float sq = xv.x * xv.x + xv.y * xv.y + xv.z * xv.z + xv.w * xv.w;
        u32x2 o; o.x = pk(xv.x, xv.y); o.y = pk(xv.z, xv.w);
        *(u32x2*)(XB + (size_t)tk * 1024 + c0) = o;
        sq += __shfl_xor(sq, 16); sq += __shfl_xor(sq, 32);
        if (fq == 0) atomicAdd(ssq1 + tk, sq);
      }
    }
  }
}

DI unsigned bar_ld(unsigned* p) { return __hip_atomic_load(p, __ATOMIC_RELAXED, __HIP_MEMORY_SCOPE_AGENT); }
DI unsigned bar_add(unsigned* p, unsigned v) { return __hip_atomic_fetch_add(p, v, __ATOMIC_RELAXED, __HIP_MEMORY_SCOPE_AGENT); }
DI unsigned xcc_id() { return (unsigned)__builtin_amdgcn_s_getreg((3 << 11) | 20) & 0xFu; }

DI void grid_barrier(unsigned* ctr, unsigned target, bool leader) {
  asm volatile("s_waitcnt vmcnt(0)" ::: "memory");
  __syncthreads();
  if (leader) {
    __builtin_amdgcn_fence(__ATOMIC_RELEASE, "agent");
    asm volatile("s_waitcnt vmcnt(0)" ::: "memory");
    bar_add(ctr, 1u);
    while (bar_ld(ctr) < target) __builtin_amdgcn_s_sleep(1);
    __builtin_amdgcn_fence(__ATOMIC_ACQUIRE, "agent");
    asm volatile("s_waitcnt vmcnt(0)" ::: "memory");
  }
  __syncthreads();
}
DI void xcd_barrier(unsigned* bar, unsigned round, const unsigned* s_nxcc, bool leader) {
  asm volatile("s_waitcnt vmcnt(0)" ::: "memory");
  __syncthreads();
  if (leader) {
    const unsigned xcc = xcc_id(), nxcc = *s_nxcc;
    const unsigned mine = bar_ld(bar + 64 + 64 * xcc);
    const unsigned old = bar_add(bar + 1088 + 64 * xcc, 1u);
    if (old + 1u == round * mine) {
      __builtin_amdgcn_fence(__ATOMIC_RELEASE, "agent");
      asm volatile("s_waitcnt vmcnt(0)" ::: "memory");
      bar_add(bar + 2112, 1u);
    }
    while (bar_ld(bar + 2112) < round * nxcc) __builtin_amdgcn_s_sleep(1);
    __builtin_amdgcn_fence(__ATOMIC_ACQUIRE, "agent");
    asm volatile("s_waitcnt vmcnt(0)" ::: "memory");
  }
  __syncthreads();
}

__global__ void __launch_bounds__(512, 1) mega_kernel(Params p0) {
  PW p;
  static_cast<Params&>(p) = p0;
  p.wv = __builtin_amdgcn_readfirstlane((int)(threadIdx.x >> 6));
  const bool leader = (tidx(p) == 0);
  __shared__ __attribute__((aligned(16))) char smem[SMEM_BYTES];
  __shared__ int s_item;
  __shared__ unsigned s_nxcc;
  cg::grid_group grid = cg::this_grid();
  if (p0.ws == nullptr) grid.sync();
  unsigned* bar = (unsigned*)(p.ws + WS_BAR);
  const unsigned G = gridDim.x;
  if (leader) bar_add(bar + 64 + 64 * xcc_id(), 1u);
  phase_prep(p, smem);
  if (leader) {
    unsigned n, tot;
    do {
      n = 0; tot = 0;
      for (int x = 0; x < 16; ++x) { const unsigned c = bar_ld(bar + 64 + 64 * x); tot += c; n += (c != 0u) ? 1u : 0u; }
      if (tot < G) __builtin_amdgcn_s_sleep(1);
    } while (tot < G);
    s_nxcc = n;
  }
  xcd_barrier(bar, 1, &s_nxcc, leader);
#pragma unroll 1
  for (int l = 0; l < 2; ++l) {
    phase_in(p, l, smem);
    xcd_barrier(bar, 3 * l + 2, &s_nxcc, leader);
    phase_mix(p, l, smem, &s_item);
    xcd_barrier(bar, 3 * l + 3, &s_nxcc, leader);
    phase_out(p, l, smem);
    if (l == 0) xcd_barrier(bar, 4, &s_nxcc, leader);
  }
}

extern "C" void kernel_launch(void* const* d_in, const int* in_sizes, int n_in, void* d_out, int out_size, void* d_ws,
                              size_t ws_size, hipStream_t stream) {
  static int grid_blocks = 0;
  if (!grid_blocks) {
    int dev = 0, cus = 0, per_cu = 0;
    (void)hipGetDevice(&dev);
    (void)hipDeviceGetAttribute(&cus, hipDeviceAttributeMultiprocessorCount, dev);
    (void)hipOccupancyMaxActiveBlocksPerMultiprocessor(&per_cu, mega_kernel, 512, 0);
    if (per_cu > 1) per_cu = 1;
    if (per_cu < 1) per_cu = 1;
    grid_blocks = cus * per_cu;
  }
  Params p{};
  p.x_prompt = (const float*)d_in[0]; p.x_sample = (const float*)d_in[1];
  p.cache_k = (const float*)d_in[2]; p.cache_v = (const float*)d_in[3];
  p.norm_g = (const float*)d_in[4]; p.w_in = (const float*)d_in[5];
  p.sgu_norm_g = (const float*)d_in[6]; p.sgu_w = (const float*)d_in[7]; p.sgu_b = (const float*)d_in[8];
  p.q_norm_g = (const float*)d_in[9]; p.k_norm_g = (const float*)d_in[10];
  p.lq1 = (const float*)d_in[11]; p.lk1 = (const float*)d_in[12]; p.lq2 = (const float*)d_in[13]; p.lk2 = (const float*)d_in[14];
  p.subln_g = (const float*)d_in[15]; p.w_out = (const float*)d_in[16];
  p.out = (float*)d_out; p.ws = (char*)d_ws;
  (void)hipMemsetAsync((char*)d_ws + WS_BAR, 0, 16384, stream);
  void* args[] = {&p};
  hipError_t e = hipLaunchCooperativeKernel((void*)mega_kernel, dim3(grid_blocks), dim3(512), args, 0, stream);
  if (e != hipSuccess) fprintf(stderr, "cooperative launch failed: %s (grid %d)\n", hipGetErrorString(e), grid_blocks);
}
```
